# Optimizing an MI355X kernel written in HIP

```python
import math
import jax, jax.numpy as jnp
from jax import lax
import numpy as np

D_MODEL = 1024
BATCH = 2
SEQ = 16384
DEPTH = 2

N_A_LAYERS = DEPTH // 2
N_B_LAYERS = DEPTH - N_A_LAYERS
GDN_HEADS = D_MODEL // 128
GDN_DK = 128
GDN_DV = 128
CONV_K = 4
CHUNK = 64
GDN_HK = GDN_HEADS * GDN_DK
GDN_HV = GDN_HEADS * GDN_DV
GDN_IN = 2 * GDN_HK + 2 * GDN_HV + 2 * GDN_HEADS
DIFF_HEADS = D_MODEL // 256
DIFF_DH = 128
DIFF_QW = DIFF_HEADS * 2 * DIFF_DH
DIFF_VW = DIFF_HEADS * 2 * DIFF_DH
ROT_DIM = DIFF_DH // 4
ROPE_THETA = 500000.0
Q_BLOCK = 128
D_FF = 4 * D_MODEL
EPS = 1e-6

kernel_name = "yoco_gdn_diffattn_adaln_trunk"


def rmsnorm(x, g):
    xf = x.astype(jnp.float32)
    y = xf * lax.rsqrt(jnp.mean(xf * xf, axis=-1, keepdims=True) + EPS)
    return (y * g.astype(jnp.float32)).astype(x.dtype)


def modulate(x, g, shift, scale):
    return rmsnorm(x, g) * (1 + scale[:, None, :]) + shift[:, None, :]


def l2norm(x):
    xf = x.astype(jnp.float32)
    return (xf * lax.rsqrt(jnp.sum(xf * xf, axis=-1, keepdims=True) + EPS)).astype(x.dtype)


def causal_conv_silu(x, w):
    K = w.shape[0]
    S = x.shape[1]
    xp = jnp.pad(x, ((0, 0), (K - 1, 0), (0, 0)))
    y = xp[:, 0:S] * w[0]
    for j in range(1, K):
        y = y + xp[:, j:j + S] * w[j]
    return jax.nn.silu(y)


def gated_delta_rule(q, k, v, g, beta):
    f32 = jnp.float32
    B, S, H, DK = q.shape
    DV = v.shape[-1]
    N = S // CHUNK

    def chunks(t):
        return t.astype(f32).reshape(B, N, CHUNK, H, -1).transpose(0, 3, 1, 2, 4)

    qc = chunks(q) * (DK ** -0.5)
    kc = chunks(k)
    vc = chunks(v)
    gc = g.astype(f32).reshape(B, N, CHUNK, H).transpose(0, 3, 1, 2)
    bc = beta.astype(f32).reshape(B, N, CHUNK, H).transpose(0, 3, 1, 2)
    gcum = jnp.cumsum(gc, axis=-1)
    idx = jnp.arange(CHUNK)
    incl = idx[:, None] >= idx[None, :]
    strict = idx[:, None] > idx[None, :]
    gdiff = gcum[..., :, None] - gcum[..., None, :]
    decay = jnp.where(incl, jnp.exp(jnp.where(incl, gdiff, 0.0)), 0.0)
    kb = kc * bc[..., None]
    a_mat = jnp.where(strict, jnp.einsum('bhnik,bhnjk->bhnij', kb, kc) * decay, 0.0)
    eye = jnp.eye(CHUNK, dtype=f32)
    rhs = jnp.concatenate([vc * bc[..., None], kb * jnp.exp(gcum)[..., None]], axis=-1)
    sol = lax.linalg.triangular_solve(eye + a_mat, rhs, left_side=True, lower=True, unit_diagonal=True)
    u = sol[..., :DV]
    w = sol[..., DV:]
    qk = jnp.einsum('bhnik,bhnjk->bhnij', qc, kc) * decay
    qg = qc * jnp.exp(gcum)[..., None]
    kdec = kc * jnp.exp(gcum[..., -1:] - gcum)[..., None]
    glast = jnp.exp(gcum[..., -1])
    xs = tuple(jnp.moveaxis(t, 2, 0) for t in (qg, qk, u, w, kdec, glast))

    def step(state, inp):
        qg_i, qk_i, u_i, w_i, kd_i, gl_i = inp
        v_new = u_i - jnp.einsum('bhck,bhkv->bhcv', w_i, state)
        o_i = jnp.einsum('bhck,bhkv->bhcv', qg_i, state) + jnp.einsum('bhij,bhjv->bhiv', qk_i, v_new)
        state = state * gl_i[..., None, None] + jnp.einsum('bhck,bhcv->bhkv', kd_i, v_new)
        return state, o_i

    s0 = jnp.zeros((B, H, DK, DV), f32)
    _, o = lax.scan(step, s0, xs)
    return o.transpose(1, 0, 3, 2, 4).reshape(B, S, H, DV)


def gated_deltanet(h, w_in, conv_w, a_log, dt_bias, out_g, w_out):
    B, S, _ = h.shape
    proj = h @ w_in
    qkv = causal_conv_silu(proj[..., :2 * GDN_HK + GDN_HV], conv_w)
    q = qkv[..., :GDN_HK].reshape(B, S, GDN_HEADS, GDN_DK)
    k = qkv[..., GDN_HK:2 * GDN_HK].reshape(B, S, GDN_HEADS, GDN_DK)
    v = qkv[..., 2 * GDN_HK:].reshape(B, S, GDN_HEADS, GDN_DV)
    off = 2 * GDN_HK + GDN_HV
    z = proj[..., off:off + GDN_HV].reshape(B, S, GDN_HEADS, GDN_DV)
    a = proj[..., off + GDN_HV:off + GDN_HV + GDN_HEADS]
    b = proj[..., off + GDN_HV + GDN_HEADS:]
    g = -jnp.exp(a_log.astype(jnp.float32)) * jax.nn.softplus(a.astype(jnp.float32) + dt_bias.astype(jnp.float32))
    beta = jax.nn.sigmoid(b.astype(jnp.float32))
    o = gated_delta_rule(l2norm(q), l2norm(k), v, g, beta).astype(h.dtype)
    o = rmsnorm(o, out_g) * jax.nn.silu(z)
    return o.reshape(B, S, GDN_HV) @ w_out


def rope_tables(S):
    pos = jnp.arange(S, dtype=jnp.float32)
    inv_freq = ROPE_THETA ** (-jnp.arange(0, ROT_DIM, 2, dtype=jnp.float32) / ROT_DIM)
    freqs = pos[:, None] * inv_freq[None, :]
    return jnp.cos(freqs), jnp.sin(freqs)


def partial_rope(x, cos, sin):
    half = ROT_DIM // 2
    xf = x.astype(jnp.float32)
    x1 = xf[..., :half]
    x2 = xf[..., half:ROT_DIM]
    c = cos[None, :, None, None, :]
    s = sin[None, :, None, None, :]
    out = jnp.concatenate([x1 * c - x2 * s, x2 * c + x1 * s, xf[..., ROT_DIM:]], axis=-1)
    return out.astype(x.dtype)


def diff_attention(q, k, v, lam):
    B, S, H, _, DH = q.shape
    nb = S // Q_BLOCK
    qb = q.reshape(B, nb, Q_BLOCK, H, 2, DH).transpose(1, 0, 3, 4, 2, 5)
    kt = k.transpose(0, 2, 3, 1, 4)
    vt = v.transpose(0, 2, 1, 3)
    kpos = jnp.arange(S)
    scale = DH ** -0.5

    def block(args):
        i, qi = args
        s = jnp.einsum('bhmqd,bhmkd->bhmqk', qi, kt).astype(jnp.float32) * scale
        qpos = i * Q_BLOCK + jnp.arange(Q_BLOCK)
        s = jnp.where(kpos[None, :] <= qpos[:, None], s, -jnp.inf)
        p = jax.nn.softmax(s, axis=-1)
        a = p[:, :, 0] - lam * p[:, :, 1]
        return jnp.einsum('bhqk,bhkv->bhqv', a.astype(v.dtype), vt)

    o = lax.map(block, (jnp.arange(nb), qb))
    return o.transpose(1, 0, 3, 2, 4).reshape(B, S, H, 2 * DH)


def diff_attn_layer(h, k, v, w_q, lam_params, subln_g, w_out, lam_init, cos, sin):
    B, S, _ = h.shape
    q = (h @ w_q).reshape(B, S, DIFF_HEADS, 2, DIFF_DH)
    q = partial_rope(q, cos, sin)
    lp = lam_params.astype(jnp.float32)
    lam = jnp.exp(jnp.sum(lp[0] * lp[1])) - jnp.exp(jnp.sum(lp[2] * lp[3])) + lam_init
    o = diff_attention(q, k, v, lam)
    o = rmsnorm(o, subln_g) * (1.0 - lam_init)
    return o.reshape(B, S, DIFF_VW) @ w_out


def sqrelu_mlp(h, w1, w2):
    return jnp.square(jax.nn.relu(h @ w1)) @ w2


def setup_inputs(seed: int = 0) -> dict:
    key = jax.random.key(seed)
    ks = jax.random.split(key, 32)
    D = D_MODEL

    def nrm(k, shape, scale):
        return jax.random.normal(k, shape, jnp.float32) * scale

    dt = jnp.exp(jax.random.uniform(ks[8], (N_A_LAYERS, GDN_HEADS), jnp.float32) * (math.log(0.1) - math.log(0.001)) + math.log(0.001))
    return {
        "x": nrm(ks[0], (BATCH, SEQ, D), 1.0),
        "c": nrm(ks[1], (BATCH, D), 1.0),
        "mod_w": nrm(ks[2], (DEPTH, D, 6 * D), 0.5 * D ** -0.5),
        "mod_b": nrm(ks[3], (DEPTH, 6 * D), 0.02),
        "norm_mix_g": 1.0 + nrm(ks[4], (DEPTH, D), 0.02),
        "norm_mlp_g": 1.0 + nrm(ks[5], (DEPTH, D), 0.02),
        "a_w_in": nrm(ks[6], (N_A_LAYERS, D, GDN_IN), D ** -0.5),
        "a_conv_w": nrm(ks[7], (N_A_LAYERS, CONV_K, 2 * GDN_HK + GDN_HV), CONV_K ** -0.5),
        "a_log": jnp.log(jax.random.uniform(ks[9], (N_A_LAYERS, GDN_HEADS), jnp.float32, 1.0, 16.0)),
        "a_dt_bias": dt + jnp.log(-jnp.expm1(-dt)),
        "a_out_norm_g": 1.0 + nrm(ks[10], (N_A_LAYERS, GDN_DV), 0.02),
        "a_w_out": nrm(ks[11], (N_A_LAYERS, GDN_HV, D), GDN_HV ** -0.5),
        "kv_mod_w": nrm(ks[12], (D, 2 * D), 0.5 * D ** -0.5),
        "kv_mod_b": nrm(ks[13], (2 * D,), 0.02),
        "kv_norm_g": 1.0 + nrm(ks[14], (D,), 0.02),
        "kv_w": nrm(ks[15], (D, DIFF_HEADS * 2 * DIFF_DH + DIFF_VW), D ** -0.5),
        "b_w_q": nrm(ks[16], (N_B_LAYERS, D, DIFF_QW), D ** -0.5),
        "b_lambda": nrm(ks[17], (N_B_LAYERS, 4, DIFF_DH), 0.1),
        "b_subln_g": 1.0 + nrm(ks[18], (N_B_LAYERS, 2 * DIFF_DH), 0.02),
        "b_w_out": nrm(ks[19], (N_B_LAYERS, DIFF_VW, D), DIFF_VW ** -0.5),
        "mlp_w1": nrm(ks[20], (DEPTH, D, D_FF), D ** -0.5),
        "mlp_w2": nrm(ks[21], (DEPTH, D_FF, D), D_FF ** -0.5),
        "final_g": 1.0 + nrm(ks[22], (D,), 0.02),
    }


def reference(x, c, mod_w, mod_b, norm_mix_g, norm_mlp_g, a_w_in, a_conv_w, a_log, a_dt_bias, a_out_norm_g, a_w_out,
              kv_mod_w, kv_mod_b, kv_norm_g, kv_w, b_w_q, b_lambda, b_subln_g, b_w_out, mlp_w1, mlp_w2, final_g):
    B, S, D = x.shape
    cs = jax.nn.silu(c)
    cos, sin = rope_tables(S)
    k_sh = None
    v_sh = None
    for l in range(DEPTH):
        mod = cs @ mod_w[l] + mod_b[l]
        sh1, sc1, gt1, sh2, sc2, gt2 = jnp.split(mod, 6, axis=-1)
        if l < N_A_LAYERS:
            h = modulate(x, norm_mix_g[l], sh1, sc1)
            y = gated_deltanet(h, a_w_in[l], a_conv_w[l], a_log[l], a_dt_bias[l], a_out_norm_g[l], a_w_out[l])
        else:
            if l == N_A_LAYERS:
                kv_sh_shift, kv_sh_scale = jnp.split(cs @ kv_mod_w + kv_mod_b, 2, axis=-1)
                kv = modulate(x, kv_norm_g, kv_sh_shift, kv_sh_scale) @ kv_w
                k_sh = partial_rope(kv[..., :DIFF_HEADS * 2 * DIFF_DH].reshape(B, S, DIFF_HEADS, 2, DIFF_DH), cos, sin)
                v_sh = kv[..., DIFF_HEADS * 2 * DIFF_DH:].reshape(B, S, DIFF_HEADS, 2 * DIFF_DH)
            j = l - N_A_LAYERS
            lam_init = 0.8 - 0.6 * math.exp(-0.3 * l)
            h = modulate(x, norm_mix_g[l], sh1, sc1)
            y = diff_attn_layer(h, k_sh, v_sh, b_w_q[j], b_lambda[j], b_subln_g[j], b_w_out[j], lam_init, cos, sin)
        x = x + gt1[:, None, :] * y
        h = modulate(x, norm_mlp_g[l], sh2, sc2)
        x = x + gt2[:, None, :] * sqrelu_mlp(h, mlp_w1[l], mlp_w2[l])
    return rmsnorm(x, final_g)
```

```cpp
#include <hip/hip_runtime.h>
#include <hip/hip_bf16.h>
#include <hip/hip_cooperative_groups.h>
#include <cstdio>
#include <cstdint>
namespace cg = cooperative_groups;
#ifndef MK_SINGLE
#define MK_SINGLE 1
#endif
typedef _Float16 h16x8 __attribute__((ext_vector_type(8)));
typedef _Float16 h16x2 __attribute__((ext_vector_type(2)));
typedef float mf32x4 __attribute__((ext_vector_type(4)));
typedef float mf32x16 __attribute__((ext_vector_type(16)));
template <class A, class B> __device__ __forceinline__ mf32x4 MFMA16(A a, B b, mf32x4 c, int = 0, int = 0, int = 0) { return __builtin_amdgcn_mfma_f32_16x16x32_f16(__builtin_bit_cast(h16x8, a), __builtin_bit_cast(h16x8, b), c, 0, 0, 0); }
template <class A, class B> __device__ __forceinline__ mf32x16 MFMA32(A a, B b, mf32x16 c, int = 0, int = 0, int = 0) { return __builtin_amdgcn_mfma_f32_32x32x16_f16(__builtin_bit_cast(h16x8, a), __builtin_bit_cast(h16x8, b), c, 0, 0, 0); }
namespace pg8 {
#define PG8_LAS __attribute__((address_space(3)))
typedef unsigned short bf16_t;
typedef short bf16x8 __attribute__((ext_vector_type(8)));
typedef float f32x4 __attribute__((ext_vector_type(4)));
typedef unsigned u32x4 __attribute__((ext_vector_type(4)));
constexpr int BM = 256, BK = 64, HALF = 128, HTB = HALF * BK * 2  , STAGE_BYTES = 8 * HTB, NXCD = 8, WGM = 8;

__host__ __device__ __forceinline__ int lds_byte(int r, int c) { const int st = (r >> 4) * 2 + (c >> 5), rr = r & 15, cc = c & 31, ob = rr * 64 + cc * 2; return st * 1024 + (ob ^ (((ob >> 9) & 1) << 5)); }
__host__ __device__ __forceinline__ void stage_rc(int b, int& R, int& C) { const int st = b / 1024, sb = b % 1024, swz = sb ^ (((sb >> 9) & 1) << 5); R = (st >> 1) * 16 + swz / 64; C = (st & 1) * 32 + (swz % 64) / 2; }
__host__ __device__ __forceinline__ int perm32(int rho) { const int n = rho >> 4, i = rho & 15; return 8 * (i >> 2) + 4 * n + (i & 3); }

struct Unit { int pm, pn; };
struct Gemm { const bf16_t* A; const bf16_t* Bt; int M, N, K; };

struct StaticOrder {
    int nM, nN, nwg, G, c;
    __host__ __device__ void init(int M, int N, int G_, int c_) { nM = M / BM; nN = N / BM; nwg = nM * nN; G = G_; c = c_; }
    __host__ __device__ bool next(int i, Unit& u) const {
        const long L = (long)i * G + c; if (L >= nwg) return false;
        int wgid = (int)L; { const int q = nwg / NXCD, r = nwg % NXCD, xcd = wgid % NXCD, off = wgid / NXCD; wgid = (xcd < r ? xcd * (q + 1) : r * (q + 1) + (xcd - r) * q) + off; }
        const int nig = WGM * nN, gid = wgid / nig, fm = gid * WGM, gsz = (nM - fm) < WGM ? (nM - fm) : WGM;
        u.pm = fm + ((wgid % nig) % gsz); u.pn = (wgid % nig) / gsz; return true;
    }
    __device__ __forceinline__ void a_ready(const Unit&) const {}
    __device__ __forceinline__ void done(const Unit&) const {}
};

__device__ __forceinline__ unsigned cvt_pk_bf16(float lo, float hi) { h16x2 v = {(_Float16)lo, (_Float16)hi}; return __builtin_bit_cast(unsigned, v); }
typedef float f32x2 __attribute__((ext_vector_type(2)));
__device__ __forceinline__ f32x2 gelu_pk(f32x2 v) {
    const f32x2 av = __builtin_elementwise_abs(v), d = av * 0.2316418882f + 1.0f;
    f32x2 t; t.x = __builtin_amdgcn_rcpf(d.x); t.y = __builtin_amdgcn_rcpf(d.y);
    f32x2 q = t * 0.5307027145f + (-0.7265760135f); q = q * t + 0.7107068705f; q = q * t + (-0.142248368f); q = q * t + 0.127414796f; q = q * t;
    const f32x2 s = (v * v) * (-0.72134752044f);
    f32x2 e; e.x = __builtin_amdgcn_exp2f(s.x); e.y = __builtin_amdgcn_exp2f(s.y);
    const f32x2 m = v * (q * e), r = v - m;
    f32x2 o; o.x = v.x < 0.f ? m.x : r.x; o.y = v.y < 0.f ? m.y : r.y; return o;
}

template <int ACT  > struct EpiBf16 {
    static constexpr bool PERM = true, AFTER_DRAIN = false; static_assert(ACT == 0 || ACT == 1, "EpiBf16: ACT is 0 (none) or 1 (gelu_pk)");
    bf16_t* O; int ldc; const float* bias; int split_cols; size_t split_stride; float scale0;
    __device__ __forceinline__ void operator()(const f32x4 (&acc)[2][2][4][2], const Unit& u, int wr, int wc, int fr, int fq) const {
        const int row0 = u.pm * BM + wr * 64 + fr; int colt = u.pn * BM; bf16_t* base = O;
        float sc = 1.f; if (split_cols) { const int t = colt / split_cols; base += (size_t)t * split_stride; colt -= t * split_cols; if (t == 0) sc = scale0; }
        const int col0 = colt + wc * 32 + 8 * fq, bcol0 = u.pn * BM + wc * 32 + 8 * fq;
        f32x4 bv[2][2];
#pragma unroll
        for (int bj = 0; bj < 2; ++bj)
#pragma unroll
            for (int n = 0; n < 2; ++n) bv[bj][n] = bias ? *(const f32x4*)(bias + bcol0 + bj * HALF + 4 * n) : (f32x4){0.f, 0.f, 0.f, 0.f};
#pragma unroll
        for (int ai = 0; ai < 2; ++ai)
#pragma unroll
            for (int m = 0; m < 4; ++m) { bf16_t* rowp = base + (size_t)(row0 + ai * HALF + m * 16) * ldc + col0;
#pragma unroll
                for (int bj = 0; bj < 2; ++bj) { f32x4 v0 = acc[ai][bj][m][0] + bv[bj][0], v1 = acc[ai][bj][m][1] + bv[bj][1];
                    if (ACT == 1) { f32x2 a = gelu_pk((f32x2){v0[0], v0[1]}), b = gelu_pk((f32x2){v0[2], v0[3]}), c = gelu_pk((f32x2){v1[0], v1[1]}), d = gelu_pk((f32x2){v1[2], v1[3]});
                        v0 = (f32x4){a.x, a.y, b.x, b.y}; v1 = (f32x4){c.x, c.y, d.x, d.y}; }
                    v0 = v0 * sc; v1 = v1 * sc; u32x4 w; w.x = cvt_pk_bf16(v0[0], v0[1]); w.y = cvt_pk_bf16(v0[2], v0[3]); w.z = cvt_pk_bf16(v1[0], v1[1]); w.w = cvt_pk_bf16(v1[2], v1[3]);
                    *(u32x4*)(rowp + bj * HALF) = w; } }
    }
};

template <class Epi, class Sched, bool ALIGN_EPI = false, bool SP2 = false>
__device__ __forceinline__ void gemm_phase(PG8_LAS unsigned char* lds, const Gemm g, const Sched& S, const Epi& E) {
    int tid = threadIdx.x; asm volatile("" : "+v"(tid));
    const int wid = __builtin_amdgcn_readfirstlane(tid >> 6), lane = tid & 63, wr = wid >> 2, wc = wid & 3, fr = lane & 15, fq = lane >> 4;
    const int K = g.K, nt = K / BK;
    unsigned voffA[2], voffB[2];
#pragma unroll
    for (int i = 0; i < 2; ++i) { int R, C; stage_rc(tid * 16 + i * 8192, R, C); const int Rb = Epi::PERM ? ((R & ~31) + perm32(R & 31)) : R;
        voffA[i] = (unsigned)(R * K + C) * 2u; voffB[i] = (unsigned)(Rb * K + C) * 2u; }
    const size_t kstep = (size_t)(BK * 2);
    const size_t hstep = (size_t)HALF * K * 2;
    const size_t tstep = 2 * hstep;
    const unsigned ldsw = (unsigned)wid * 1024u;
    const int aoff = lds_byte(wr * 64 + fr, fq * 8), boff = lds_byte(wc * 32 + fr, fq * 8);
#define PG8_SA(b, h) (((b) * 2 + (h)) * HTB)
#define PG8_SB(b, h) ((4 + (b) * 2 + (h)) * HTB)
#define PG8_STAGE(bufoff, gbase, voff) do { _Pragma("unroll") for (int _i = 0; _i < 2; ++_i) \
        __builtin_amdgcn_global_load_lds((const unsigned*)((const char*)(gbase) + (voff)[_i]), (PG8_LAS unsigned*)(lds + (bufoff) + ldsw + _i * 8192), 16, 0, 0); } while (0)
#define PG8_LDA(dst, b, h) do { _Pragma("unroll") for (int m = 0; m < 4; ++m) _Pragma("unroll") for (int k = 0; k < 2; ++k) dst[m][k] = *(const PG8_LAS bf16x8*)(lds + PG8_SA(b, h) + aoff + m * 2048 + k * 1024); } while (0)
#define PG8_LDB(dst, b, h) do { _Pragma("unroll") for (int n = 0; n < 2; ++n) _Pragma("unroll") for (int k = 0; k < 2; ++k) dst[n][k] = *(const PG8_LAS bf16x8*)(lds + PG8_SB(b, h) + boff + n * 2048 + k * 1024); } while (0)
#define PG8_MMA(ai, bj, At, Bt) do { __builtin_amdgcn_s_setprio(1); _Pragma("unroll") for (int m = 0; m < 4; ++m) _Pragma("unroll") for (int n = 0; n < 2; ++n) _Pragma("unroll") for (int k = 0; k < 2; ++k) \
        acc[ai][bj][m][n] = MFMA16(Bt[n][k], At[m][k], acc[ai][bj][m][n], 0, 0, 0); __builtin_amdgcn_s_setprio(0); } while (0)
#define PG8_WAIT_V(n) asm volatile("s_waitcnt vmcnt(" #n ")" ::: "memory")
#define PG8_WAIT_L(n) asm volatile("s_waitcnt lgkmcnt(" #n ")" ::: "memory")
#define PG8_BAR __builtin_amdgcn_s_barrier()
#define PG8_SCHED __builtin_amdgcn_sched_barrier(0)
    Unit cur, nxt; int ui = 0;
    if (!S.next(0, cur)) return;
    f32x4 acc[2][2][4][2];
#pragma unroll
    for (int a = 0; a < 2; ++a)
#pragma unroll
        for (int b = 0; b < 2; ++b)
#pragma unroll
            for (int m = 0; m < 4; ++m)
#pragma unroll
                for (int n = 0; n < 2; ++n) acc[a][b][m][n] = (f32x4){0.f, 0.f, 0.f, 0.f};
    bf16x8 At[4][2], B0[2][2], B1[2][2];
    const char* cA = (const char*)g.A + (size_t)cur.pm * tstep; const char* cB = (const char*)g.Bt + (size_t)cur.pn * tstep;
    S.a_ready(cur);
    if constexpr (SP2) {
        PG8_STAGE(PG8_SB(0, 0), cB, voffB); PG8_STAGE(PG8_SB(0, 1), cB + hstep, voffB); PG8_STAGE(PG8_SA(0, 0), cA, voffA); PG8_STAGE(PG8_SA(0, 1), cA + hstep, voffA);
        if (wr == 1) PG8_BAR;
        PG8_WAIT_V(2); PG8_BAR;
        PG8_STAGE(PG8_SB(1, 0), cB + kstep, voffB); PG8_STAGE(PG8_SA(1, 0), cA + kstep, voffA); PG8_STAGE(PG8_SB(1, 1), cB + hstep + kstep, voffB);
        PG8_WAIT_V(6); PG8_BAR;
    } else {
        PG8_STAGE(PG8_SB(0, 0), cB, voffB); PG8_STAGE(PG8_SA(0, 0), cA, voffA); PG8_STAGE(PG8_SB(0, 1), cB + hstep, voffB); PG8_STAGE(PG8_SA(0, 1), cA + hstep, voffA);
        if (wr == 1) PG8_BAR;
        PG8_WAIT_V(4); PG8_BAR;
        PG8_STAGE(PG8_SB(1, 0), cB + kstep, voffB); PG8_STAGE(PG8_SA(1, 0), cA + kstep, voffA); PG8_STAGE(PG8_SB(1, 1), cB + hstep + kstep, voffB);
        PG8_WAIT_V(6); PG8_BAR;
    }
    for (;;) {
        const bool has_next = S.next(ui + 1, nxt);
        const char* nA = has_next ? (const char*)g.A + (size_t)nxt.pm * tstep : cA; const char* nB = has_next ? (const char*)g.Bt + (size_t)nxt.pn * tstep : cB;
        for (int t = 0; t < nt; t += 2) {
            const bool last = (t == nt - 2);
            const char* a1 = cA + (size_t)(t + 1) * kstep;
            const char* a2 = last ? nA : cA + (size_t)(t + 2) * kstep; const char* b2 = last ? nB : cB + (size_t)(t + 2) * kstep;
            const char* a3 = a2 + kstep; const char* b3 = b2 + kstep;
            if (last && has_next) S.a_ready(nxt);
            if constexpr (SP2) {
            PG8_LDB(B0, 0, 0); PG8_LDB(B1, 0, 1); PG8_SCHED; PG8_LDA(At, 0, 0); PG8_STAGE(PG8_SA(1, 1), a1 + hstep, voffA);
            PG8_WAIT_V(8); PG8_WAIT_L(0); PG8_BAR; PG8_MMA(0, 0, At, B0); PG8_MMA(0, 1, At, B1); PG8_BAR; PG8_SCHED;
            PG8_LDA(At, 0, 1); PG8_STAGE(PG8_SB(0, 0), b2, voffB); PG8_STAGE(PG8_SB(0, 1), b2 + hstep, voffB); PG8_STAGE(PG8_SA(0, 0), a2, voffA);
            PG8_WAIT_V(8); PG8_WAIT_L(0); PG8_BAR; PG8_MMA(1, 0, At, B0); PG8_MMA(1, 1, At, B1); PG8_BAR; PG8_SCHED;
            PG8_LDB(B0, 1, 0); PG8_LDB(B1, 1, 1); PG8_SCHED; PG8_LDA(At, 1, 0); PG8_STAGE(PG8_SA(0, 1), a2 + hstep, voffA);
            PG8_WAIT_V(8); PG8_WAIT_L(0); PG8_BAR; PG8_MMA(0, 0, At, B0); PG8_MMA(0, 1, At, B1); PG8_BAR; PG8_SCHED;
            PG8_LDA(At, 1, 1); PG8_STAGE(PG8_SB(1, 0), b3, voffB); PG8_STAGE(PG8_SB(1, 1), b3 + hstep, voffB); PG8_STAGE(PG8_SA(1, 0), a3, voffA);
            PG8_WAIT_V(8); PG8_WAIT_L(0); PG8_BAR; PG8_MMA(1, 0, At, B0); PG8_MMA(1, 1, At, B1); PG8_BAR; PG8_SCHED;
            } else {
            PG8_LDB(B0, 0, 0); PG8_SCHED; PG8_LDA(At, 0, 0); PG8_STAGE(PG8_SA(1, 1), a1 + hstep, voffA);
            PG8_WAIT_L(8); PG8_BAR; PG8_WAIT_L(0); PG8_MMA(0, 0, At, B0); PG8_BAR; PG8_SCHED;
            PG8_LDB(B1, 0, 1); PG8_STAGE(PG8_SB(0, 0), b2, voffB);
            PG8_BAR; PG8_WAIT_L(0); PG8_MMA(0, 1, At, B1); PG8_BAR;
            PG8_LDA(At, 0, 1); PG8_STAGE(PG8_SA(0, 0), a2, voffA);
            PG8_BAR; PG8_WAIT_L(0); PG8_MMA(1, 0, At, B0); PG8_BAR; PG8_SCHED;
            PG8_STAGE(PG8_SB(0, 1), b2 + hstep, voffB);
            PG8_WAIT_V(6); PG8_BAR; PG8_MMA(1, 1, At, B1); PG8_BAR;
            PG8_LDB(B0, 1, 0); PG8_SCHED; PG8_LDA(At, 1, 0); PG8_STAGE(PG8_SA(0, 1), a2 + hstep, voffA);
            PG8_WAIT_L(8); PG8_BAR; PG8_WAIT_L(0); PG8_MMA(0, 0, At, B0); PG8_BAR; PG8_SCHED;
            PG8_LDB(B1, 1, 1); PG8_STAGE(PG8_SB(1, 0), b3, voffB);
            PG8_BAR; PG8_WAIT_L(0); PG8_MMA(0, 1, At, B1); PG8_BAR;
            PG8_LDA(At, 1, 1); PG8_STAGE(PG8_SA(1, 0), a3, voffA);
            PG8_BAR; PG8_WAIT_L(0); PG8_MMA(1, 0, At, B0); PG8_BAR; PG8_SCHED;
            PG8_STAGE(PG8_SB(1, 1), b3 + hstep, voffB);
            PG8_WAIT_V(6); PG8_BAR; PG8_MMA(1, 1, At, B1); PG8_BAR;
            }
        }
        if constexpr (ALIGN_EPI) { if (wr == 0) PG8_BAR; }
        if constexpr (!Epi::AFTER_DRAIN) { E(acc, cur, wr, wc, fr, fq); S.done(cur); }
        if (!has_next) break;
#pragma unroll
        for (int a = 0; a < 2; ++a)
#pragma unroll
            for (int b = 0; b < 2; ++b)
#pragma unroll
                for (int m = 0; m < 4; ++m)
#pragma unroll
                    for (int n = 0; n < 2; ++n) acc[a][b][m][n] = (f32x4){0.f, 0.f, 0.f, 0.f};
        cur = nxt; cA = nA; cB = nB; ++ui;
        if constexpr (ALIGN_EPI) { if (wr == 1) PG8_BAR; }
    }
    PG8_WAIT_V(0);
    if constexpr (!ALIGN_EPI) { if (wr == 0) PG8_BAR; }
    PG8_BAR;
    if constexpr (Epi::AFTER_DRAIN) { E.fused(acc, cur, wr, wc, fr, fq, lds, wid, lane); S.done(cur); }
#undef PG8_SA
#undef PG8_SB
#undef PG8_STAGE
#undef PG8_LDA
#undef PG8_LDB
#undef PG8_MMA
#undef PG8_WAIT_V
#undef PG8_WAIT_L
#undef PG8_BAR
#undef PG8_SCHED
}
}
namespace pg8 {
typedef unsigned u32x2 __attribute__((ext_vector_type(2)));
struct EpiStoreBf16 {
    static constexpr bool PERM = true, AFTER_DRAIN = false;
    bf16_t* O; int ldc; int act;
    __device__ __forceinline__ void operator()(const f32x4 (&acc)[2][2][4][2], const Unit& u, int wr, int wc, int fr, int fq) const {
        const int row0 = u.pm * BM + wr * 64 + fr; const int col0 = u.pn * BM + wc * 32 + 8 * fq;
#pragma unroll
        for (int ai = 0; ai < 2; ++ai)
#pragma unroll
            for (int m = 0; m < 4; ++m) { bf16_t* rowp = O + (size_t)(row0 + ai * HALF + m * 16) * ldc + col0;
#pragma unroll
                for (int bj = 0; bj < 2; ++bj) { f32x4 v0 = acc[ai][bj][m][0], v1 = acc[ai][bj][m][1];
                    if (act == 1) {
#pragma unroll
                        for (int e = 0; e < 4; ++e) { float a = fmaxf(v0[e], 0.f), b = fmaxf(v1[e], 0.f); v0[e] = a * a; v1[e] = b * b; } }
                    u32x4 w; w.x = cvt_pk_bf16(v0[0], v0[1]); w.y = cvt_pk_bf16(v0[2], v0[3]); w.z = cvt_pk_bf16(v1[0], v1[1]); w.w = cvt_pk_bf16(v1[2], v1[3]);
                    *(u32x4*)(rowp + bj * HALF) = w; } }
    }
};
struct EpiResid {
    static constexpr bool PERM = false, AFTER_DRAIN = false;
    const float* base; float* out; const float* gate; int gstride;
    __device__ __forceinline__ void operator()(const f32x4 (&acc)[2][2][4][2], const Unit& u, int wr, int wc, int fr, int fq) const {
        const int row0 = u.pm * BM + wr * 64 + fr; const int col0 = u.pn * BM + wc * 32 + 4 * fq;
        const float* gp = gate + (size_t)(u.pm >= 64 ? gstride : 0) + col0;
#pragma unroll
        for (int bj = 0; bj < 2; ++bj)
#pragma unroll
            for (int n = 0; n < 2; ++n) { const f32x4 gv = *(const f32x4*)(gp + bj * HALF + n * 16);
#pragma unroll
                for (int ai = 0; ai < 2; ++ai)
#pragma unroll
                    for (int m = 0; m < 4; ++m) { const size_t off = (size_t)(row0 + ai * HALF + m * 16) * 1024 + col0 + bj * HALF + n * 16;
                        const f32x4 bs = *(const f32x4*)(base + off); *(f32x4*)(out + off) = bs + gv * acc[ai][bj][m][n]; } }
    }
};
struct EpiRope {
    static constexpr bool PERM = false, AFTER_DRAIN = false;
    bf16_t* dstK; bf16_t* dstV; const float* cs; const float* sn; int nrope;
    __device__ __forceinline__ void operator()(const f32x4 (&acc)[2][2][4][2], const Unit& u, int wr, int wc, int fr_, int fq_) const {
        int fr = fr_, fq = fq_; asm volatile("" : "+v"(fr), "+v"(fq));
        const int b = u.pm >> 6, s0 = (u.pm & 63) * 256; const bool rope = u.pn < nrope; const int head = rope ? u.pn : u.pn - nrope;
        bf16_t* dst = rope ? dstK : dstV;
#pragma unroll
        for (int ai = 0; ai < 2; ++ai)
#pragma unroll
            for (int m = 0; m < 4; ++m) { const int srow = s0 + ai * HALF + wr * 64 + m * 16 + fr;
                f32x4 c4 = {1.f, 1.f, 1.f, 1.f}, s4 = {0.f, 0.f, 0.f, 0.f};
                if (rope && wc == 0) { c4 = *(const f32x4*)(cs + (size_t)srow * 16 + 4 * fq); s4 = *(const f32x4*)(sn + (size_t)srow * 16 + 4 * fq); }
#pragma unroll
                for (int bj = 0; bj < 2; ++bj) { bf16_t* bp = dst + ((size_t)((b * 4 + head) * 2 + bj) * 16384 + srow) * 128 + wc * 32 + 4 * fq;
                    f32x4 v0 = acc[ai][bj][m][0], v1 = acc[ai][bj][m][1];
                    if (rope && wc == 0) { const f32x4 o0 = v0 * c4 - v1 * s4, o1 = v1 * c4 + v0 * s4; v0 = o0; v1 = o1; }
                    u32x2 w0, w1; w0.x = cvt_pk_bf16(v0[0], v0[1]); w0.y = cvt_pk_bf16(v0[2], v0[3]); w1.x = cvt_pk_bf16(v1[0], v1[1]); w1.y = cvt_pk_bf16(v1[2], v1[3]);
                    *(u32x2*)bp = w0; *(u32x2*)(bp + 16) = w1; }
                asm volatile("" ::: "memory"); }
    }
};
}
namespace att {
constexpr int D = 128, OLD = 1024;
constexpr float THR = 8.f; constexpr bool WSKIP = false;
using bf16 = __hip_bfloat16;
typedef short bf16x8 __attribute__((ext_vector_type(8)));
typedef short s16x4 __attribute__((ext_vector_type(4)));
typedef float f32x16 __attribute__((ext_vector_type(16)));
typedef float f32x4 __attribute__((ext_vector_type(4)));
typedef unsigned u32x4 __attribute__((ext_vector_type(4)));
template <class A, class Bt> struct same_t { static constexpr bool v = false; };
template <class A> struct same_t<A, A> { static constexpr bool v = true; };
constexpr float SCALE = 0.08838834764831845f;
constexpr int NW = 8, QBLK = 32, KVBLK = 64, QB = NW * QBLK;
constexpr int SHM_V = KVBLK * D * 2, SHM_K = KVBLK * D * 2;
constexpr int ATT_LDS_BYTES = 2 * SHM_V + 2 * SHM_K + NW * 64 * 4;


#define KSWZ(row, colB) ((row) * 256 + ((colB) ^ (((row) & 7) << 4)))
#define SBAR() __builtin_amdgcn_sched_barrier(0)
__device__ __forceinline__ int v_st(int k, int c) { const int kk = (k & ~0xC) | ((k & 4) << 1) | ((k & 8) >> 1); return ((kk >> 3) * 4 + (c >> 5)) * 512 + ((kk & 7) * 32 + (c & 31)) * 2; }
__device__ __forceinline__ int v_rd_base(int lane) { return ((lane & 3) << 3) | (((lane >> 2) & 3) << 6) | (((lane >> 4) & 1) << 5) | (((lane >> 5) & 1) << 8); }
constexpr int v_rd_off(int d0, int ks, int half) { return d0 * 512 + ks * 4096 + half * 2048; }
__device__ __forceinline__ int crow(int r, int hi) { return (r & 3) + 8 * (r >> 2) + 4 * hi; }
__device__ __forceinline__ unsigned cvtpk(float lo, float hi) {
    unsigned r; asm volatile("v_cvt_pk_f16_f32 %0, %1, %2" : "=v"(r) : "v"(lo), "v"(hi)); return r;
}
__device__ __forceinline__ bf16x8 pack8(f32x4 a, f32x4 b) {
    u32x4 w = {cvtpk(a[0], a[1]), cvtpk(a[2], a[3]), cvtpk(b[0], b[1]), cvtpk(b[2], b[3])};
    return *reinterpret_cast<bf16x8*>(&w);
}
template <class T> __device__ __forceinline__ bf16x8 load8(const T* p) {
    if constexpr (same_t<T, float>::v) { return pack8(*(const f32x4*)p, *(const f32x4*)(p + 4)); }
    else { return *reinterpret_cast<const bf16x8*>(p); }
}
__device__ __forceinline__ void mask_tile(f32x16& p0, f32x16& p1, int dq, unsigned W) {
    const float NEG = -__builtin_inff();
#pragma unroll
    for (int r = 0; r < 16; ++r) {
        const int c = (r & 3) + 8 * (r >> 2);
        if ((unsigned)(dq - c) >= W) p0[r] = NEG;
        if ((unsigned)(dq - c - 32) >= W) p1[r] = NEG;
    }
}
__device__ __forceinline__ void partialSM(f32x16& p0, f32x16& p1, float& m_reg, float& mn, float& alpha) {
    float pmax = p0[0]; for (int r = 1; r < 16; ++r) pmax = fmaxf(pmax, p0[r]); for (int r = 0; r < 16; ++r) pmax = fmaxf(pmax, p1[r]);
    { auto rr = __builtin_amdgcn_permlane32_swap(__float_as_uint(pmax), __float_as_uint(pmax), false, false);
      pmax = fmaxf(__uint_as_float(rr[0]), __uint_as_float(rr[1])); }
    constexpr float C2 = 1.4426950408889634f * SCALE;
    if (__builtin_expect(__all((pmax - m_reg) * SCALE <= THR), 1)) { mn = m_reg; alpha = 1.f; }
    else { mn = fmaxf(m_reg, pmax); alpha = __builtin_amdgcn_exp2f((m_reg - mn) * C2); m_reg = mn; }
    const float mnL = -mn * C2;
    for (int r = 0; r < 16; ++r) p0[r] = fmaf(p0[r], C2, mnL); for (int r = 0; r < 16; ++r) p1[r] = fmaf(p1[r], C2, mnL);
    for (int r = 0; r < 16; ++r) p0[r] = __builtin_amdgcn_exp2f(p0[r]);
}
__device__ __forceinline__ void finishSM(f32x16& p0, f32x16& p1, float alpha, float& l_reg, bf16x8& pa0, bf16x8& pa1, bf16x8& pa2, bf16x8& pa3) {
    for (int r = 0; r < 16; ++r) p1[r] = __builtin_amdgcn_exp2f(p1[r]);
    float ps = 0; for (int r = 0; r < 16; ++r) ps += p0[r]; for (int r = 0; r < 16; ++r) ps += p1[r];
    { auto rr = __builtin_amdgcn_permlane32_swap(__float_as_uint(ps), __float_as_uint(ps), false, false);
      ps = __uint_as_float(rr[0]) + __uint_as_float(rr[1]); }
    l_reg = l_reg * alpha + ps;
#define PK4(P, B_, OUT) do { unsigned a0 = cvtpk(P[B_+0], P[B_+1]), a1 = cvtpk(P[B_+2], P[B_+3]);                          \
        unsigned b0 = cvtpk(P[B_+4], P[B_+5]), b1 = cvtpk(P[B_+6], P[B_+7]);                                             \
        auto r0 = __builtin_amdgcn_permlane32_swap(a0, b0, false, false); auto r1 = __builtin_amdgcn_permlane32_swap(a1, b1, false, false); \
        u32x4 w = {r0[0], r1[0], r0[1], r1[1]}; OUT = *reinterpret_cast<bf16x8*>(&w); } while (0)
    PK4(p0, 0, pa0); PK4(p0, 8, pa1); PK4(p1, 0, pa2); PK4(p1, 8, pa3);
#undef PK4
}
template <int KB, bool SK>
__device__ __forceinline__ void qkt(f32x16& p0, f32x16& p1, const char* K_lds, int r32, int hi, const bf16x8* qr, bool act) {
    if (SK && !act) { const float NEG = -__builtin_inff();
#pragma unroll
        for (int r = 0; r < 16; ++r) { p0[r] = NEG; p1[r] = NEG; } return; }
    p0 = f32x16{}; p1 = f32x16{};
    const char* kb[4];
#pragma unroll
    for (int dd = 0; dd < 4; ++dd) kb[dd] = K_lds + KB * SHM_K + KSWZ(r32, (dd * 16 + hi * 8) * 2);
#pragma unroll
    for (int d0 = 0; d0 < 8; ++d0) { const char* a = kb[d0 & 3] + (d0 >> 2) * 128;
        bf16x8 b0 = *reinterpret_cast<const bf16x8*>(a);
        bf16x8 b1 = *reinterpret_cast<const bf16x8*>(a + 32 * 256);
        p0 = MFMA32(b0, qr[d0], p0, 0, 0, 0);
        p1 = MFMA32(b1, qr[d0], p1, 0, 0, 0); }
}
template <int VB, bool SK>
__device__ __forceinline__ void pv_tile(f32x16* o, int vb0, bf16x8 pa0, bf16x8 pa1, bf16x8 pa2, bf16x8 pa3, bool act) {
    if (SK && !act) return;
#define TRRD(dst, off) asm volatile("ds_read_b64_tr_b16 %0, %1 offset:%2" : "=&v"(dst) : "v"(vb0), "i"(off) : "memory")
#define PV_D0(d0) do { s16x4 l0, l1, l2, l3, h0, h1, h2, h3; constexpr int b_ = VB * SHM_V + v_rd_off(d0, 0, 0);     \
        TRRD(l0, b_); TRRD(h0, b_ + 2048); TRRD(l1, b_ + 4096); TRRD(h1, b_ + 6144); TRRD(l2, b_ + 8192); TRRD(h2, b_ + 10240); TRRD(l3, b_ + 12288); TRRD(h3, b_ + 14336); \
        asm volatile("s_waitcnt lgkmcnt(0)" ::: "memory"); SBAR();                 \
        o[d0] = MFMA32(pa0, (bf16x8){l0[0], l0[1], l0[2], l0[3], h0[0], h0[1], h0[2], h0[3]}, o[d0], 0, 0, 0);   \
        o[d0] = MFMA32(pa1, (bf16x8){l1[0], l1[1], l1[2], l1[3], h1[0], h1[1], h1[2], h1[3]}, o[d0], 0, 0, 0);   \
        o[d0] = MFMA32(pa2, (bf16x8){l2[0], l2[1], l2[2], l2[3], h2[0], h2[1], h2[2], h2[3]}, o[d0], 0, 0, 0);   \
        o[d0] = MFMA32(pa3, (bf16x8){l3[0], l3[1], l3[2], l3[3], h3[0], h3[1], h3[2], h3[3]}, o[d0], 0, 0, 0); } while (0)
    PV_D0(0); PV_D0(1); PV_D0(2); PV_D0(3);
#undef PV_D0
#undef TRRD
}

template <class TIn, class TOut> struct BlockRef { const TIn* Q; const TIn* K; const TIn* V; TOut* O; int P0; };
template <class TIn> struct Seam {
    bf16x8 qr[8];
    bf16x8 st_v0, st_v1, st_k0, st_k1; f32x4 sf0, sf1, sf2, sf3;
    f32x4 tq[16];
};
__device__ __forceinline__ int swa_jlo(int P0, int W) { const int lowk = P0 - W + 1; return lowk > 0 ? lowk / KVBLK : 0; }
#define ROW(p, k0, rr) ((p) + (size_t)((k0) + (rr)) * D + sc)
#define VMW() asm volatile("s_waitcnt vmcnt(0)" ::: "memory")
#define VMWN(n) asm volatile("s_waitcnt vmcnt(%0)" :: "i"(n) : "memory")
#define SLOAD_H(Kp, Vp, k0) do { S.st_v0 = load8<TIn>(ROW(Vp, k0, sr)); S.st_v1 = load8<TIn>(ROW(Vp, k0, 32 + sr));              \
                         S.st_k0 = load8<TIn>(ROW(Kp, k0, sr)); S.st_k1 = load8<TIn>(ROW(Kp, k0, 32 + sr)); } while (0)
#define SWRITE_HK(bf) do { *(bf16x8*)(K_lds + (bf) * SHM_K + kws) = S.st_k0; *(bf16x8*)(K_lds + (bf) * SHM_K + kws + 32 * 256) = S.st_k1; } while (0)
#define SWRITE_HV(bf) do { *(bf16x8*)(V_lds + (bf) * SHM_V + vst0) = S.st_v0; *(bf16x8*)(V_lds + (bf) * SHM_V + vst1) = S.st_v1; } while (0)
#define SWRITE_H(bf) do { SWRITE_HV(bf); SWRITE_HK(bf); } while (0)
#define SLOAD_F(p, k0) do { S.sf0 = *(const f32x4*)ROW(p, k0, sr); S.sf1 = *(const f32x4*)(ROW(p, k0, sr) + 4);                \
                            S.sf2 = *(const f32x4*)ROW(p, k0, 32 + sr); S.sf3 = *(const f32x4*)(ROW(p, k0, 32 + sr) + 4); } while (0)
#define SWRITE_KF(bf) do { *(bf16x8*)(K_lds + (bf) * SHM_K + kws) = pack8(S.sf0, S.sf1); *(bf16x8*)(K_lds + (bf) * SHM_K + kws + 32 * 256) = pack8(S.sf2, S.sf3); } while (0)
#define SWRITE_VF(bf) do { *(bf16x8*)(V_lds + (bf) * SHM_V + vst0) = pack8(S.sf0, S.sf1); *(bf16x8*)(V_lds + (bf) * SHM_V + vst1) = pack8(S.sf2, S.sf3); } while (0)
template <class TIn, class TOut>
__device__ __forceinline__ void causal_swa_prime(const BlockRef<TIn, TOut>& cur, int W, char* lds, Seam<TIn>& S) {
    constexpr bool F32 = same_t<TIn, float>::v;
    const int tid = threadIdx.x, wid = __builtin_amdgcn_readfirstlane(tid >> 6), lane = tid & 63, r32 = lane & 31, hi = lane >> 5;
    const int sr = tid >> 4, sc = (tid & 15) * 8, kws = KSWZ(sr, sc * 2); char* K_lds = lds + 2 * SHM_V;
    const int kb0 = swa_jlo(cur.P0, W) * KVBLK;
    for (int d0 = 0; d0 < 8; ++d0) S.qr[d0] = load8<TIn>(cur.Q + (size_t)(wid * QBLK + r32) * D + d0 * 16 + hi * 8);
    if constexpr (F32) { SLOAD_F((const float*)cur.K, kb0); VMW(); SWRITE_KF(0); SBAR(); SLOAD_F((const float*)cur.V, kb0); }
    else { SLOAD_H(cur.K, cur.V, kb0); VMW(); SWRITE_HK(0); }
    __syncthreads();
}
template <class TIn, class TOut>
__device__ __forceinline__ void causal_swa_block(const BlockRef<TIn, TOut>& cur, const BlockRef<TIn, TOut>& nxt, int skv, int W, char* lds, Seam<TIn>& S) {
    constexpr bool F32 = same_t<TIn, float>::v;
    const int tid = threadIdx.x, wid = __builtin_amdgcn_readfirstlane(tid >> 6), lane = tid & 63, r32 = lane & 31, hi = lane >> 5;
    const int j_lo = swa_jlo(cur.P0, W);
    int j_hi = (cur.P0 + QB - 1) / KVBLK + 1; if (j_hi > skv / KVBLK) j_hi = skv / KVBLK;
    const int NT = j_hi - j_lo;
    const int kbn = swa_jlo(nxt.P0, W) * KVBLK;
    const int qlo = cur.P0 + wid * QBLK, qm = qlo + r32 - 4 * hi;
    char* V_lds = lds; char* K_lds = lds + 2 * SHM_V;
    float* ws = (float*)(lds + 2 * SHM_V + 2 * SHM_K) + wid * 64; float* li_l = ws, * al_l = ws + 32;
    float m_reg = -1e30f, l_reg = 0; f32x16 o[4] = {};
    const int sr = tid >> 4, sc = (tid & 15) * 8, vst0 = v_st(sr, sc), vst1 = v_st(32 + sr, sc), kws = KSWZ(sr, sc * 2);
    const int vb0 = (int)(uintptr_t)V_lds + v_rd_base(lane);
    const TIn* Kh = cur.K; const TIn* Vh = cur.V;
#define RESC(a) do { if (__any((a) < 1.f)) { if (hi == 0) al_l[r32] = (a); asm volatile("s_waitcnt lgkmcnt(0)" ::: "memory");              \
                     for (int d_ = 0; d_ < 4; ++d_) for (int r = 0; r < 16; ++r) o[d_][r] *= al_l[crow(r, hi)]; } } while (0)
#define KBASE(t) ((j_lo + (t)) * KVBLK)
#define ACT(t) (KBASE(t) <= qlo + QBLK - 1 && KBASE(t) + KVBLK - 1 >= qlo - W + 1)
#define MASKT(P0_, P1_, t) do { const int kb_ = KBASE(t); if ((!SK || ACT(t)) && (kb_ + KVBLK - 1 > qlo || kb_ <= qlo + QBLK - 1 - W)) mask_tile(P0_, P1_, qm - kb_, (unsigned)W); } while (0)
    constexpr int NQL = F32 ? 16 : 8;
    constexpr bool SK = WSKIP && !F32;
#define SEAM_K0() do { VMWN(NQL); if constexpr (F32) { SWRITE_KF(0); SBAR(); SLOAD_F((const float*)nxt.V, kbn); } else { SWRITE_HK(0); } SBAR(); } while (0)
    f32x16 pA0, pA1, pB0, pB1; float mnA, mnB, alA, alB; bf16x8 pa0, pa1, pa2, pa3;
    if constexpr (F32) { VMW(); SWRITE_VF(0); SBAR(); } else { SWRITE_HV(0); SBAR(); }
    if (NT > 1) { if constexpr (F32) SLOAD_F((const float*)Kh, KBASE(1)); else SLOAD_H(Kh, Vh, KBASE(1)); }
    SBAR(); qkt<0, SK>(pA0, pA1, K_lds, r32, hi, S.qr, ACT(0));
    if constexpr (F32) { if (NT > 1) { VMW(); SWRITE_KF(1); SBAR(); SLOAD_F((const float*)Vh, KBASE(1)); } }
    MASKT(pA0, pA1, 0); partialSM(pA0, pA1, m_reg, mnA, alA);
    if (NT > 1) { VMW(); if constexpr (F32) { SWRITE_VF(1); SBAR(); if (NT > 2) SLOAD_F((const float*)Kh, KBASE(2)); } else SWRITE_H(1); }
    __syncthreads();
#define HALF_STEP(PX0, PX1, mnX, alX, PY0, PY1, alY, t, KB, VB, SB) do {                                                      \
        SBAR(); qkt<KB, SK>(PX0, PX1, K_lds, r32, hi, S.qr, ACT(t));                                             \
        finishSM(PY0, PY1, alY, l_reg, pa0, pa1, pa2, pa3); SBAR();                                                           \
        if ((t) + 1 < NT) { if constexpr (F32) { VMW(); SWRITE_KF(SB); SBAR(); SLOAD_F((const float*)Vh, KBASE((t) + 1)); }  \
                            else { SLOAD_H(Kh, Vh, KBASE((t) + 1)); } SBAR(); }                                               \
        pv_tile<VB, SK>(o, vb0, pa0, pa1, pa2, pa3, ACT((t) - 1)); MASKT(PX0, PX1, (t)); partialSM(PX0, PX1, m_reg, mnX, alX);                                        \
        __syncthreads();                                                                                                      \
        if ((t) + 1 < NT) { VMW(); if constexpr (F32) { SWRITE_VF(SB); SBAR(); if ((t) + 2 < NT) SLOAD_F((const float*)Kh, KBASE((t) + 2)); } \
                            else { SWRITE_H(SB); } }                                                                          \
        RESC(alX); __syncthreads(); } while (0)
    for (int t = 1; t + 1 < NT; t += 2) {
        HALF_STEP(pB0, pB1, mnB, alB, pA0, pA1, alA, t, 1, 0, 0);
        HALF_STEP(pA0, pA1, mnA, alA, pB0, pB1, alB, t + 1, 0, 1, 1);
    }
    const bool even = (NT & 1) == 0;
    if (even) { SBAR(); qkt<1, SK>(pB0, pB1, K_lds, r32, hi, S.qr, ACT(NT - 1)); SBAR(); }
#define QROW(e) (nxt.Q + (size_t)(wid * QBLK + r32) * D + ((e) >> 1) * 16 + hi * 8 + ((e) & 1) * 4)
    if constexpr (F32) { SLOAD_F((const float*)nxt.K, kbn); SBAR();
#pragma unroll
        for (int e = 0; e < 8; ++e) S.tq[e] = *(const f32x4*)QROW(e); }
    else { SLOAD_H(nxt.K, nxt.V, kbn); SBAR();
#pragma unroll
        for (int d0 = 0; d0 < 8; ++d0) S.qr[d0] = load8<TIn>(nxt.Q + (size_t)(wid * QBLK + r32) * D + d0 * 16 + hi * 8); }
    SBAR();
    finishSM(pA0, pA1, alA, l_reg, pa0, pa1, pa2, pa3); SBAR();
    if constexpr (F32) {
#pragma unroll
        for (int e = 8; e < 16; ++e) S.tq[e] = *(const f32x4*)QROW(e); SBAR(); }
#undef QROW
    pv_tile<0, SK>(o, vb0, pa0, pa1, pa2, pa3, ACT(even ? NT - 2 : NT - 1));
    if (even) { MASKT(pB0, pB1, NT - 1); partialSM(pB0, pB1, m_reg, mnB, alB); __syncthreads(); RESC(alB);
        finishSM(pB0, pB1, alB, l_reg, pa0, pa1, pa2, pa3); SBAR(); pv_tile<1, SK>(o, vb0, pa0, pa1, pa2, pa3, ACT(NT - 1)); }
    SBAR(); SEAM_K0();
    if (hi == 0) li_l[r32] = l_reg; asm volatile("s_waitcnt lgkmcnt(0)" ::: "memory");
    float rli[16];
#pragma unroll
    for (int r = 0; r < 16; ++r) rli[r] = __builtin_amdgcn_rcpf(li_l[crow(r, hi)]);
    TOut* Ow = cur.O + (size_t)(wid * QBLK) * OLD;
#pragma unroll
    for (int r = 0; r < 16; ++r) { const int orow = crow(r, hi);
#pragma unroll
        for (int d0 = 0; d0 < 4; ++d0) { const float v = o[d0][r] * rli[r];
            if constexpr (same_t<TOut, float>::v) { Ow[(size_t)orow * OLD + d0 * 32 + r32] = v; }
            else { const float vn = __shfl_xor(v, 1);
                   if ((r32 & 1) == 0) *(unsigned*)(Ow + (size_t)orow * OLD + d0 * 32 + r32) = cvtpk(v, vn); } } }
    if constexpr (F32) {
#pragma unroll
        for (int d0 = 0; d0 < 8; ++d0) S.qr[d0] = pack8(S.tq[2 * d0], S.tq[2 * d0 + 1]); }
    __syncthreads();
#undef RESC
#undef KBASE
#undef ACT
#undef MASKT
#undef SEAM_K0
#undef HALF_STEP
}
#undef ROW
#undef VMW
#undef VMWN
#undef SLOAD_H
#undef SWRITE_HK
#undef SWRITE_HV
#undef SWRITE_H
#undef SLOAD_F
#undef SWRITE_KF
#undef SWRITE_VF

}
#define LAS __attribute__((address_space(3)))
typedef unsigned short bf16_t;
typedef float f32x4 __attribute__((ext_vector_type(4)));
typedef float f32x2 __attribute__((ext_vector_type(2)));
typedef short bf16x8 __attribute__((ext_vector_type(8)));
typedef unsigned u32x4 __attribute__((ext_vector_type(4)));
typedef unsigned u32x2 __attribute__((ext_vector_type(2)));
constexpr int SEQ = 16384, DM = 1024, TT = 2 * SEQ, FF = 4096, NPH = 22;
constexpr size_t MiB = 1u << 20;
constexpr size_t WS_MOD = 0, WS_KVMOD = 128 * 1024, WS_ROPEC = 1 * MiB, WS_ROPES = 2 * MiB, WS_G = 3 * MiB, WS_BETA = 4 * MiB, WS_STATE = 5 * MiB, WS_GL = 6 * MiB;
constexpr size_t WS_WIN = 16 * MiB, WS_WAO = 24 * MiB, WS_WKV = 26 * MiB, WS_WQ = 30 * MiB, WS_WBO = 32 * MiB, WS_W1 = 34 * MiB, WS_W2 = 42 * MiB;
constexpr size_t WS_HB = 66 * MiB, WS_HB2 = 130 * MiB, WS_PREP = 66 * MiB, WS_O = 66 * MiB, WS_BIG = 256 * MiB, WS_HB3 = 448 * MiB, WS_END = 512 * MiB;
constexpr size_t CHUNK_ELEMS = 36864;
constexpr int LDS_BYTES = 147456;
constexpr float EPSN = 1e-6f;

__device__ __forceinline__ unsigned cvtpk(float lo, float hi) { h16x2 v = {(_Float16)lo, (_Float16)hi}; return __builtin_bit_cast(unsigned, v); }
__device__ __forceinline__ float bflo(unsigned w) { return (float)__builtin_bit_cast(h16x2, w)[0]; }
__device__ __forceinline__ float bfhi(unsigned w) { return (float)__builtin_bit_cast(h16x2, w)[1]; }
__device__ __forceinline__ float wave_sum(float v) {
#pragma unroll
    for (int o = 1; o < 64; o <<= 1) v += __shfl_xor(v, o);
    return v;
}
__device__ __forceinline__ float siluf(float y) { return y * __builtin_amdgcn_rcpf(1.f + __expf(-y)); }
__device__ __forceinline__ bf16x8 pack8(f32x4 a, f32x4 b) { u32x4 w = {cvtpk(a[0], a[1]), cvtpk(a[2], a[3]), cvtpk(b[0], b[1]), cvtpk(b[2], b[3])}; return *reinterpret_cast<bf16x8*>(&w); }

struct Params { const float* in[23]; float* out; unsigned char* ws; int ph_lo, ph_hi; };

__device__ __forceinline__ void p0_transpose_item(const float* W, int K, int N, int ldw, bf16_t* WT, LAS float* scr, int item, int lane) {
    const int nblk = N / 32, kb = item / nblk, nb = item % nblk, k0 = 64 * kb, n0 = 32 * nb;
#pragma unroll 8
    for (int i = 0; i < 32; ++i) { const int kk = 2 * i + (lane >> 5); scr[kk * 33 + (lane & 31)] = W[(size_t)(k0 + kk) * ldw + n0 + (lane & 31)]; }
    asm volatile("s_waitcnt lgkmcnt(0)" ::: "memory");
    const int c = lane & 7;
#pragma unroll
    for (int j = 0; j < 4; ++j) { const int n = (lane >> 3) + 8 * j; const LAS float* s = scr + (8 * c) * 33 + n;
        u32x4 o; o.x = cvtpk(s[0 * 33], s[1 * 33]); o.y = cvtpk(s[2 * 33], s[3 * 33]); o.z = cvtpk(s[4 * 33], s[5 * 33]); o.w = cvtpk(s[6 * 33], s[7 * 33]);
        *(u32x4*)(WT + (size_t)(n0 + n) * K + k0 + 8 * c) = o; }
    asm volatile("s_waitcnt lgkmcnt(0)" ::: "memory");
}

__device__ __forceinline__ void p0_weights(const Params& p, LAS unsigned char* lds, int part, int wgr, int Gr, int tid) {
    const int wave = tid >> 6, lane = tid & 63;
    unsigned char* ws = p.ws;
    {
        LAS float* scr = (LAS float*)(lds + wave * 16384);
        const int gw = wgr * 8 + wave, NGW = Gr * 8;
        constexpr int I_IN = 16 * 128, I_SQ = 16 * 32, I_KV = 16 * 64, I_1 = 16 * 128, I_2 = 64 * 32;
        constexpr int NITEMS = I_IN + 3 * I_SQ + I_KV + 2 * I_1 + 2 * I_2;
        for (int it = (part ? I_IN : 0) + gw; it < (part ? NITEMS : I_IN); it += NGW) {
            int r = it;
            if (r < I_IN) { p0_transpose_item(p.in[6], 1024, 4096, 4112, (bf16_t*)(ws + WS_WIN), scr, r, lane); continue; } r -= I_IN;
            if (r < I_SQ) { p0_transpose_item(p.in[11], 1024, 1024, 1024, (bf16_t*)(ws + WS_WAO), scr, r, lane); continue; } r -= I_SQ;
            if (r < I_KV) { p0_transpose_item(p.in[15], 1024, 2048, 2048, (bf16_t*)(ws + WS_WKV), scr, r, lane); continue; } r -= I_KV;
            if (r < I_SQ) { p0_transpose_item(p.in[16], 1024, 1024, 1024, (bf16_t*)(ws + WS_WQ), scr, r, lane); continue; } r -= I_SQ;
            if (r < I_SQ) { p0_transpose_item(p.in[19], 1024, 1024, 1024, (bf16_t*)(ws + WS_WBO), scr, r, lane); continue; } r -= I_SQ;
            if (r < I_1) { p0_transpose_item(p.in[20], 1024, 4096, 4096, (bf16_t*)(ws + WS_W1), scr, r, lane); continue; } r -= I_1;
            if (r < I_1) { p0_transpose_item(p.in[20] + (size_t)1024 * 4096, 1024, 4096, 4096, (bf16_t*)(ws + WS_W1 + 16 * MiB), scr, r, lane); continue; } r -= I_1;
            if (r < I_2) { p0_transpose_item(p.in[21], 4096, 1024, 1024, (bf16_t*)(ws + WS_W2), scr, r, lane); continue; } r -= I_2;
            p0_transpose_item(p.in[21] + (size_t)4096 * 1024, 4096, 1024, 1024, (bf16_t*)(ws + WS_W2 + 16 * MiB), scr, r, lane);
        }
    }
}
__device__ __forceinline__ void p0_prologue(const Params& p, LAS unsigned char* lds, int wg, int G, int tid) {
    const int wave = tid >> 6, lane = tid & 63;
    unsigned char* ws = p.ws;
    p0_weights(p, lds, 0, wg, G, tid);
    __syncthreads();
    {
        float* rc = (float*)(ws + WS_ROPEC); float* rs = (float*)(ws + WS_ROPES);
        for (int idx = wg * 512 + tid; idx < SEQ * 16; idx += G * 512) {
            const int pos = idx >> 4, i = idx & 15;
            const double invf = exp(-(double)i * (1.0 / 16.0) * 13.122363377404328);
            const double rev = (double)pos * invf * 0.15915494309189535; const float fr = (float)(rev - floor(rev));
            rc[idx] = __builtin_amdgcn_cosf(fr); rs[idx] = __builtin_amdgcn_sinf(fr);
        }
    }
    {
        LAS float* cs = (LAS float*)lds;
        LAS float* part = (LAS float*)(lds + 8192);
        for (int i = tid; i < 2048; i += 512) cs[i] = siluf(p.in[1][i]);
        __syncthreads();
        for (int cb = wg; cb < 224; cb += G) {
            const float* W; int ld, n0; const float* bias; float* outp; int ostride;
            if (cb < 192) { const int l = cb / 96; n0 = (cb % 96) * 64; W = p.in[2] + (size_t)l * 1024 * 6144; ld = 6144; bias = p.in[3] + l * 6144; outp = (float*)(ws + WS_MOD) + l * 2 * 6144; ostride = 6144; }
            else { n0 = (cb - 192) * 64; W = p.in[12]; ld = 2048; bias = p.in[13]; outp = (float*)(ws + WS_KVMOD); ostride = 2048; }
            float a0 = 0.f, a1 = 0.f;
#pragma unroll 8
            for (int k = wave * 128; k < wave * 128 + 128; ++k) { const float w = W[(size_t)k * ld + n0 + lane]; a0 += cs[k] * w; a1 += cs[1024 + k] * w; }
            part[(wave * 2 + 0) * 64 + lane] = a0; part[(wave * 2 + 1) * 64 + lane] = a1;
            __syncthreads();
            if (tid < 128) { const int b = tid >> 6, c = tid & 63; float s = 0.f;
#pragma unroll
                for (int w = 0; w < 8; ++w) s += part[(w * 2 + b) * 64 + c];
                outp[b * ostride + n0 + c] = s + bias[n0 + c]; }
            __syncthreads();
        }
    }
}

__device__ __forceinline__ float reduce16_to_lane(const float (&acc)[16], int lane) {
    float r[8], s4[4], t2[2];
#pragma unroll
    for (int i = 0; i < 8; ++i) { const bool hi = lane & 1; const float keep = hi ? acc[2 * i + 1] : acc[2 * i], send = hi ? acc[2 * i] : acc[2 * i + 1]; r[i] = keep + __shfl_xor(send, 1); }
#pragma unroll
    for (int i = 0; i < 4; ++i) { const bool hi = lane & 2; const float keep = hi ? r[2 * i + 1] : r[2 * i], send = hi ? r[2 * i] : r[2 * i + 1]; s4[i] = keep + __shfl_xor(send, 2); }
#pragma unroll
    for (int i = 0; i < 2; ++i) { const bool hi = lane & 4; const float keep = hi ? s4[2 * i + 1] : s4[2 * i], send = hi ? s4[2 * i] : s4[2 * i + 1]; t2[i] = keep + __shfl_xor(send, 4); }
    const bool hi = lane & 8; float u = (hi ? t2[1] : t2[0]) + __shfl_xor(hi ? t2[0] : t2[1], 8);
    u += __shfl_xor(u, 16); u += __shfl_xor(u, 32);
    return u;
}
template <bool AB>
__device__ __forceinline__ void modulate_phase(const Params& p, LAS unsigned char* lds, const float* src, const float* g, const float* shift, const float* scale, int bstride,
                                               bf16_t* dst, int wg, int G, int tid) {
    const int wave = tid >> 6, lane = tid & 63, gw = wg * 8 + wave, NGW = G * 8;
    LAS float* wab = (LAS float*)lds;
    if (AB) {
        const float* win = p.in[6];
        for (int idx = tid; idx < 16384; idx += 512) { const int k = idx >> 4, c = idx & 15; wab[c * 1024 + k] = win[(size_t)k * 4112 + 4096 + c]; }
        __syncthreads();
    }
    for (int b = 0; b < 2; ++b) {
        f32x4 gs[4], sh[4];
#pragma unroll
        for (int j = 0; j < 4; ++j) { const int c = 4 * lane + 256 * j; const f32x4 gv = *(const f32x4*)(g + c), sc = *(const f32x4*)(scale + b * bstride + c); gs[j] = gv * (sc + 1.f); sh[j] = *(const f32x4*)(shift + b * bstride + c); }
        for (int m = b * SEQ + gw; m < (b + 1) * SEQ; m += 2 * NGW) {
            const int m1 = (m + NGW < (b + 1) * SEQ) ? m + NGW : m;
            const f32x4* xr0 = (const f32x4*)(src + (size_t)m * DM) + lane; const f32x4* xr1 = (const f32x4*)(src + (size_t)m1 * DM) + lane;
            f32x4 v0[4], v1[4]; float s0 = 0.f, s1 = 0.f;
#pragma unroll
            for (int j = 0; j < 4; ++j) { v0[j] = xr0[64 * j]; v1[j] = xr1[64 * j]; }
#pragma unroll
            for (int j = 0; j < 4; ++j) { s0 += (v0[j].x * v0[j].x + v0[j].y * v0[j].y) + (v0[j].z * v0[j].z + v0[j].w * v0[j].w); s1 += (v1[j].x * v1[j].x + v1[j].y * v1[j].y) + (v1[j].z * v1[j].z + v1[j].w * v1[j].w); }
            const float rstd0 = rsqrtf(wave_sum(s0) * (1.f / DM) + EPSN), rstd1 = rsqrtf(wave_sum(s1) * (1.f / DM) + EPSN);
            u32x2* o0 = (u32x2*)(dst + (size_t)m * DM) + lane; u32x2* o1 = (u32x2*)(dst + (size_t)m1 * DM) + lane;
#pragma unroll
            for (int j = 0; j < 4; ++j) { v0[j] = v0[j] * rstd0 * gs[j] + sh[j]; v1[j] = v1[j] * rstd1 * gs[j] + sh[j];
                u32x2 w; w.x = cvtpk(v0[j].x, v0[j].y); w.y = cvtpk(v0[j].z, v0[j].w); o0[64 * j] = w; w.x = cvtpk(v1[j].x, v1[j].y); w.y = cvtpk(v1[j].z, v1[j].w); o1[64 * j] = w; }
            if (AB) {
                asm volatile("" ::: "memory");
                float acc0[16], acc1[16];
#pragma unroll
                for (int c = 0; c < 16; ++c) { float a0 = 0.f, a1 = 0.f;
#pragma unroll
                    for (int j = 0; j < 4; ++j) { const f32x4 w = *(const LAS f32x4*)(wab + c * 1024 + 4 * lane + 256 * j);
                        a0 += (v0[j].x * w.x + v0[j].y * w.y) + (v0[j].z * w.z + v0[j].w * w.w); a1 += (v1[j].x * w.x + v1[j].y * w.y) + (v1[j].z * w.z + v1[j].w * w.w); }
                    acc0[c] = a0; acc1[c] = a1; }
                const float u0 = reduce16_to_lane(acc0, lane), u1 = reduce16_to_lane(acc1, lane);
                if (lane < 16) { const int hl = lane & 7;
                    if (lane < 8) { const float al = -expf(p.in[8][hl]), db = p.in[9][hl];
                        const float x0 = u0 + db, x1 = u1 + db;
                        ((float*)(p.ws + WS_G))[(size_t)m * 8 + hl] = al * (fmaxf(x0, 0.f) + log1pf(expf(-fabsf(x0))));
                        ((float*)(p.ws + WS_G))[(size_t)m1 * 8 + hl] = al * (fmaxf(x1, 0.f) + log1pf(expf(-fabsf(x1))));
                    } else {
                        ((float*)(p.ws + WS_BETA))[(size_t)m * 8 + hl] = 1.f / (1.f + expf(-u0));
                        ((float*)(p.ws + WS_BETA))[(size_t)m1 * 8 + hl] = 1.f / (1.f + expf(-u1));
                    } }
            }
        }
    }
}
__device__ __forceinline__ void modulate2_phase(const float* src, const float* g1, const float* shift1, const float* scale1, int bs1, bf16_t* dst1,
                                                const float* g2, const float* shift2, const float* scale2, int bs2, bf16_t* dst2, int wg, int G, int tid) {
    const int wave = tid >> 6, lane = tid & 63, gw = wg * 8 + wave, NGW = G * 8;
    for (int b = 0; b < 2; ++b) {
        f32x4 gs1[4], sh1[4], gs2[4], sh2[4];
#pragma unroll
        for (int j = 0; j < 4; ++j) { const int c = 4 * lane + 256 * j;
            gs1[j] = *(const f32x4*)(g1 + c) * (*(const f32x4*)(scale1 + b * bs1 + c) + 1.f); sh1[j] = *(const f32x4*)(shift1 + b * bs1 + c);
            gs2[j] = *(const f32x4*)(g2 + c) * (*(const f32x4*)(scale2 + b * bs2 + c) + 1.f); sh2[j] = *(const f32x4*)(shift2 + b * bs2 + c); }
        for (int m = b * SEQ + gw; m < (b + 1) * SEQ; m += NGW) {
            const f32x4* xr = (const f32x4*)(src + (size_t)m * DM) + lane;
            f32x4 v[4]; float s = 0.f;
#pragma unroll
            for (int j = 0; j < 4; ++j) { v[j] = xr[64 * j]; s += (v[j].x * v[j].x + v[j].y * v[j].y) + (v[j].z * v[j].z + v[j].w * v[j].w); }
            const float rstd = rsqrtf(wave_sum(s) * (1.f / DM) + EPSN);
            u32x2* o1 = (u32x2*)(dst1 + (size_t)m * DM) + lane; u32x2* o2 = (u32x2*)(dst2 + (size_t)m * DM) + lane;
#pragma unroll
            for (int j = 0; j < 4; ++j) { const f32x4 xn = v[j] * rstd; const f32x4 a = xn * gs1[j] + sh1[j], c2 = xn * gs2[j] + sh2[j];
                u32x2 w; w.x = cvtpk(a.x, a.y); w.y = cvtpk(a.z, a.w); o1[64 * j] = w; w.x = cvtpk(c2.x, c2.y); w.y = cvtpk(c2.z, c2.w); o2[64 * j] = w; }
        }
    }
}
__device__ __forceinline__ void gate_phase(const float* o, const bf16_t* proj, const float* outg, bf16_t* dst, int wg, int G, int tid) {
    const int wave = tid >> 6, lane = tid & 63, gw = wg * 8 + wave, NGW = G * 8;
    const f32x4 gv = *(const f32x4*)(outg + ((4 * lane) & 127));
    for (int m = gw; m < TT; m += NGW) {
        const u32x2* xr = (const u32x2*)((const bf16_t*)o + (size_t)m * DM) + lane; const u32x2* zr = (const u32x2*)(proj + (size_t)m * 4096 + 3072) + lane;
        u32x2* o8 = (u32x2*)(dst + (size_t)m * DM) + lane;
#pragma unroll
        for (int j = 0; j < 4; ++j) { const u32x2 ov = xr[64 * j]; const f32x4 v = {bflo(ov.x), bfhi(ov.x), bflo(ov.y), bfhi(ov.y)}; const u32x2 zz = zr[64 * j];
            float s = (v.x * v.x + v.y * v.y) + (v.z * v.z + v.w * v.w);
#pragma unroll
            for (int ofs = 1; ofs < 32; ofs <<= 1) s += __shfl_xor(s, ofs);
            const float rstd = rsqrtf(s * (1.f / 128.f) + EPSN);
            const f32x4 r = v * rstd * gv;
            u32x2 w; w.x = cvtpk(r.x * siluf(bflo(zz.x)), r.y * siluf(bfhi(zz.x))); w.y = cvtpk(r.z * siluf(bflo(zz.y)), r.w * siluf(bfhi(zz.y))); o8[64 * j] = w; }
    }
}
__device__ __forceinline__ void combine_phase(const Params& p, const bf16_t* O, bf16_t* dst, int wg, int G, int tid) {
    const int wave = tid >> 6, lane = tid & 63, gw = wg * 8 + wave, NGW = G * 8;
    const float lam_init = 0.8f - 0.6f * 0.7408182206817179f;
    const float* lp = p.in[17];
    float d1 = lp[lane] * lp[128 + lane] + lp[64 + lane] * lp[192 + lane], d2 = lp[256 + lane] * lp[384 + lane] + lp[320 + lane] * lp[448 + lane];
    const float lam = expf(wave_sum(d1)) - expf(wave_sum(d2)) + lam_init;
    const f32x4 gv = *(const f32x4*)(p.in[18] + 4 * lane) * (1.f - lam_init);
    for (int m = gw; m < TT; m += NGW) {
        const u32x2* a = (const u32x2*)(O + (size_t)m * DM) + lane; const u32x2* b = (const u32x2*)(O + (size_t)(TT + m) * DM) + lane;
        u32x2* o8 = (u32x2*)(dst + (size_t)m * DM) + lane;
#pragma unroll
        for (int j = 0; j < 4; ++j) { const u32x2 x1 = a[64 * j], x2 = b[64 * j];
            f32x4 v = {bflo(x1.x) - lam * bflo(x2.x), bfhi(x1.x) - lam * bfhi(x2.x), bflo(x1.y) - lam * bflo(x2.y), bfhi(x1.y) - lam * bfhi(x2.y)};
            const float s = wave_sum((v.x * v.x + v.y * v.y) + (v.z * v.z + v.w * v.w));
            const float rstd = rsqrtf(s * (1.f / 256.f) + EPSN);
            v = v * rstd * gv; u32x2 w; w.x = cvtpk(v.x, v.y); w.y = cvtpk(v.z, v.w); o8[64 * j] = w; }
    }
}
__device__ __forceinline__ void final_phase(float* x, const float* g, int wg, int G, int tid) {
    const int wave = tid >> 6, lane = tid & 63, gw = wg * 8 + wave, NGW = G * 8;
    f32x4 gs[4];
#pragma unroll
    for (int j = 0; j < 4; ++j) gs[j] = *(const f32x4*)(g + 4 * lane + 256 * j);
    for (int m = gw; m < TT; m += NGW) {
        f32x4* xr = (f32x4*)(x + (size_t)m * DM) + lane; f32x4 v[4]; float s = 0.f;
#pragma unroll
        for (int j = 0; j < 4; ++j) { v[j] = xr[64 * j]; s += (v[j].x * v[j].x + v[j].y * v[j].y) + (v[j].z * v[j].z + v[j].w * v[j].w); }
        const float rstd = rsqrtf(wave_sum(s) * (1.f / DM) + EPSN);
#pragma unroll
        for (int j = 0; j < 4; ++j) xr[64 * j] = v[j] * rstd * gs[j];
    }
}

template <int J> __device__ __forceinline__ void solve_load(f32x4 (&a)[16], const LAS float* AT) {
#pragma unroll
    for (int ib = (J + 1) / 4; ib < 16; ++ib) a[ib] = *(const LAS f32x4*)(AT + J * 68 + 4 * ib);
}
template <int J> __device__ __forceinline__ void solve_step(float (&x)[64], const f32x4 (&cur)[16], const LAS float* AT) {
    if constexpr (J < 63) {
        f32x4 nxt[16];
        if constexpr (J + 1 < 63) solve_load<J + 1>(nxt, AT);
#pragma unroll
        for (int ib = (J + 1) / 4; ib < 16; ++ib) {
#pragma unroll
            for (int e = 0; e < 4; ++e) { if (4 * ib + e > J) x[4 * ib + e] -= cur[ib][e] * x[J]; } }
        __builtin_amdgcn_sched_barrier(0);
        solve_step<J + 1>(x, nxt, AT);
    }
}
template <int J0, int J1> __device__ __forceinline__ void solve_range(float (&x)[64], const LAS float* AT) {
    f32x4 cur[16]; solve_load<J0>(cur, AT); solve_step<J0>(x, cur, AT);
}
constexpr int L_AT = 0, L_QS = 17408, L_KN = 34816, L_KF = 52224, L_VF = 84992, L_GC = 117760, L_BT = 118016, L_EG = 118272;
__device__ __forceinline__ void prep_phase(const Params& p, LAS unsigned char* lds, int q, int ufirst, int ustride, int ucnt, int tid_in) {
    const bf16_t* proj = (const bf16_t*)(p.ws + WS_BIG); const float* convw = p.in[7];
    const float* Gp = (const float*)(p.ws + WS_G); const float* Bp = (const float*)(p.ws + WS_BETA);
    LAS bf16_t* QS = (LAS bf16_t*)(lds + L_QS); LAS bf16_t* KN = (LAS bf16_t*)(lds + L_KN);
    LAS float* KF = (LAS float*)(lds + L_KF); LAS float* VF = (LAS float*)(lds + L_VF); LAS float* AT = (LAS float*)(lds + L_AT);
    LAS float* GC = (LAS float*)(lds + L_GC); LAS float* BT = (LAS float*)(lds + L_BT); LAS float* EG = (LAS float*)(lds + L_EG);
#pragma unroll 1
    for (int ui = 0; ui < ucnt; ++ui) { const int u = ufirst + ui * ustride;
        const int bh = u >> 6, nl = u & 63, b = bh >> 3, h = bh & 7, ng = q * 64 + nl;
        const size_t tb = (size_t)b * SEQ + (size_t)ng * 64;
        bf16_t* cb = (bf16_t*)(p.ws + WS_PREP) + (size_t)((q & 1) * 1024 + u) * CHUNK_ELEMS;
        int tid = tid_in; asm volatile("" : "+v"(tid));
        if (tid < 64) { const int lane = tid;
            float gv = Gp[(tb + lane) * 8 + h];
#pragma unroll
            for (int d = 1; d < 64; d <<= 1) { const float t = __shfl_up(gv, d); if (lane >= d) gv += t; }
            GC[lane] = gv; BT[lane] = Bp[(tb + lane) * 8 + h]; EG[lane] = __expf(gv);
            if (lane == 63) ((float*)(p.ws + WS_GL))[(q & 1) * 1024 + u] = __expf(gv);
        }
        __syncthreads();
        if (tid < 384) {
            const int cgi = tid % 48, rs = tid / 48, mat = cgi >> 4, c0 = (cgi & 15) * 8, r0 = rs * 8;
            const int ch = mat * 1024 + h * 128 + c0;
            float val[8][8];
            {
                f32x4 w[4][2];
#pragma unroll
                for (int j = 0; j < 4; ++j) { w[j][0] = *(const f32x4*)(convw + j * 3072 + ch); w[j][1] = *(const f32x4*)(convw + j * 3072 + ch + 4); }
                u32x4 raw[11];
#pragma unroll
                for (int rr = 0; rr < 11; ++rr) { const int sq = ng * 64 + r0 - 3 + rr; const bool ok = sq >= 0;
                    const bf16_t* sp = proj + ((size_t)b * SEQ + (ok ? sq : 0)) * 4096 + ch; u32x4 t = *(const u32x4*)sp; if (!ok) t = (u32x4){0u, 0u, 0u, 0u}; raw[rr] = t; }
#pragma unroll
                for (int r = 0; r < 8; ++r) { float ss = 0.f;
#pragma unroll
                    for (int e = 0; e < 8; ++e) { float a = 0.f;
#pragma unroll
                        for (int j = 0; j < 4; ++j) { const unsigned wd = raw[r + j][e >> 1]; const float xv = (e & 1) ? bfhi(wd) : bflo(wd); a += w[j][e >> 2][e & 3] * xv; }
                        const float y = siluf(a); val[r][e] = y; ss += y * y; }
                    ss += __shfl_xor(ss, 1); ss += __shfl_xor(ss, 2); ss += __shfl_xor(ss, 4); ss += __shfl_xor(ss, 8);
                    const float rstd = (mat < 2) ? rsqrtf(ss + EPSN) : 1.f;
#pragma unroll
                    for (int e = 0; e < 8; ++e) val[r][e] *= rstd; }
            }
            const float glast = GC[63];
#pragma unroll
            for (int r = 0; r < 8; ++r) { const int row = r0 + r;
                if (mat == 0) { const float eg = EG[row];
                    float q[8];
#pragma unroll
                    for (int e = 0; e < 8; ++e) q[e] = val[r][e] * 0.08838834764831845f;
                    u32x4 w = {cvtpk(q[0], q[1]), cvtpk(q[2], q[3]), cvtpk(q[4], q[5]), cvtpk(q[6], q[7])};
                    *(LAS u32x4*)(QS + row * 136 + c0) = w;
                    const int kb = c0 >> 5, j0 = c0 & 31, hi = j0 >> 4, q4 = (j0 & 15) >> 2;
                    bf16_t* d = cb + 8192 + row * 128 + 32 * kb + 8 * q4 + 4 * hi;
                    u32x2 g0 = {cvtpk(q[0] * eg, q[1] * eg), cvtpk(q[2] * eg, q[3] * eg)}, g1 = {cvtpk(q[4] * eg, q[5] * eg), cvtpk(q[6] * eg, q[7] * eg)};
                    *(u32x2*)d = g0; *(u32x2*)(d + 8) = g1;
                } else if (mat == 1) { const float be = BT[row] * EG[row]; const float kd = __expf(glast - GC[row]);
                    float k[8];
#pragma unroll
                    for (int e = 0; e < 8; ++e) { k[e] = val[r][e]; val[r][e] = k[e] * kd; }
                    u32x4 w = {cvtpk(k[0], k[1]), cvtpk(k[2], k[3]), cvtpk(k[4], k[5]), cvtpk(k[6], k[7])};
                    *(LAS u32x4*)(KN + row * 136 + c0) = w;
                    *(LAS f32x4*)(KF + row * 128 + c0) = (f32x4){k[0] * be, k[1] * be, k[2] * be, k[3] * be};
                    *(LAS f32x4*)(KF + row * 128 + c0 + 4) = (f32x4){k[4] * be, k[5] * be, k[6] * be, k[7] * be};
                } else { const float bt = BT[row];
                    *(LAS f32x4*)(VF + row * 128 + c0) = (f32x4){val[r][0] * bt, val[r][1] * bt, val[r][2] * bt, val[r][3] * bt};
                    *(LAS f32x4*)(VF + row * 128 + c0 + 4) = (f32x4){val[r][4] * bt, val[r][5] * bt, val[r][6] * bt, val[r][7] * bt};
                } }
            if (mat == 1) {
                const int jb = r0 >> 5, j0 = r0 & 31, hi = j0 >> 4, q4 = (j0 & 15) >> 2;
#pragma unroll
                for (int e = 0; e < 8; ++e) { bf16_t* d = cb + 16384 + (c0 + e) * 64 + 32 * jb + 8 * q4 + 4 * hi;
                    u32x2 a0 = {cvtpk(val[0][e], val[1][e]), cvtpk(val[2][e], val[3][e])}, a1 = {cvtpk(val[4][e], val[5][e]), cvtpk(val[6][e], val[7][e])};
                    *(u32x2*)d = a0; *(u32x2*)(d + 8) = a1; }
            }
        }
        __syncthreads();
        asm volatile("" : "+v"(tid));
        {
            const int fr = tid & 15, fq = (tid >> 4) & 3, wave = __builtin_amdgcn_readfirstlane(tid >> 6);
#pragma unroll
            for (int tt = 0; tt < 2; ++tt) { const int tile = wave * 2 + tt, mt = tile >> 2, nt = tile & 3;
                if (mt >= nt) {
                    f32x4 acc = {0.f, 0.f, 0.f, 0.f};
#pragma unroll
                    for (int ks = 0; ks < 4; ++ks) { const bf16x8 a = *(const LAS bf16x8*)(KN + (16 * mt + fr) * 136 + 32 * ks + 8 * fq), bb = *(const LAS bf16x8*)(KN + (16 * nt + fr) * 136 + 32 * ks + 8 * fq);
                        acc = MFMA16(a, bb, acc, 0, 0, 0); }
                    const int j = 16 * nt + fr; const float gj = GC[j]; f32x4 o;
#pragma unroll
                    for (int e = 0; e < 4; ++e) { const int i = 16 * mt + 4 * fq + e; o[e] = (i > j) ? BT[i] * acc[e] * __expf(GC[i] - gj) : 0.f; }
                    *(LAS f32x4*)(AT + j * 68 + 16 * mt + 4 * fq) = o;
                }
                u32x2 w = {0u, 0u};
                const int i = 16 * nt + fr;
                if (nt >= mt) {
                    f32x4 acc = {0.f, 0.f, 0.f, 0.f};
#pragma unroll
                    for (int ks = 0; ks < 4; ++ks) { const bf16x8 a = *(const LAS bf16x8*)(KN + (16 * mt + fr) * 136 + 32 * ks + 8 * fq), bb = *(const LAS bf16x8*)(QS + (16 * nt + fr) * 136 + 32 * ks + 8 * fq);
                        acc = MFMA16(a, bb, acc, 0, 0, 0); }
                    const float gi = GC[i]; float o[4];
#pragma unroll
                    for (int e = 0; e < 4; ++e) { const int j = 16 * mt + 4 * fq + e; o[e] = (i >= j) ? acc[e] * __expf(gi - GC[j]) : 0.f; }
                    w.x = cvtpk(o[0], o[1]); w.y = cvtpk(o[2], o[3]);
                }
                *(u32x2*)(cb + 32768 + i * 64 + 32 * (mt >> 1) + 8 * fq + 4 * (mt & 1)) = w;
            }
        }
        __syncthreads();
        asm volatile("" : "+v"(tid));
        if (tid < 256) {
            LAS float* MF = (tid < 128) ? (VF + tid) : (KF + (tid - 128));
            float x[64];
#pragma unroll
            for (int r = 0; r < 64; ++r) x[r] = MF[r * 128];
            solve_range<0, 63>(x, AT);
#pragma unroll
            for (int r = 0; r < 64; ++r) MF[r * 128] = x[r];
        }
        __syncthreads();
        asm volatile("" : "+v"(tid));
        { const int dv = tid & 127, rseg = tid >> 7; float uu[16];
#pragma unroll
            for (int r = 0; r < 16; ++r) uu[r] = VF[(16 * rseg + r) * 128 + dv];
            u32x4 w0 = {cvtpk(uu[0], uu[1]), cvtpk(uu[2], uu[3]), cvtpk(uu[4], uu[5]), cvtpk(uu[6], uu[7])}, w1 = {cvtpk(uu[8], uu[9]), cvtpk(uu[10], uu[11]), cvtpk(uu[12], uu[13]), cvtpk(uu[14], uu[15])};
            bf16_t* d = cb + 24576 + dv * 64 + 16 * rseg; *(u32x4*)d = w0; *(u32x4*)(d + 8) = w1; }
        { const int r = tid >> 3, cgp = tid & 7, kb = cgp >> 1, hi = cgp & 1;
#pragma unroll
            for (int g = 0; g < 4; ++g) { const f32x4 v = *(const LAS f32x4*)(KF + r * 128 + 16 * cgp + 4 * g); u32x2 w = {cvtpk(v.x, v.y), cvtpk(v.z, v.w)};
                *(u32x2*)(cb + r * 128 + 32 * kb + 8 * g + 4 * hi) = w; } }
        __syncthreads();
    }
}

constexpr int SC_W = 0, SC_QG = 17408, SC_KD = 34816, SC_QK = 53248, SC_UT = 62464, SC_BUF = 64768;
__device__ __forceinline__ void scan_piece(int q, int dv0, int& src, int& dst) {
    if (q < 2048) { const int r = q >> 10, w = q & 1023; src = q * 16; dst = r * 17408 + (w >> 4) * 272 + (w & 15) * 16; }
    else if (q < 3072) { const int w = q - 2048; src = q * 16; dst = SC_KD + (w >> 3) * 144 + (w & 7) * 16; }
    else if (q < 3584) { const int w = q - 3072; src = 65536 + w * 16; dst = SC_QK + (w >> 3) * 144 + (w & 7) * 16; }
    else { const int w = q - 3584; src = 49152 + (dv0 + (w >> 3)) * 128 + (w & 7) * 16; dst = SC_UT + (w >> 3) * 144 + (w & 7) * 16; }
}
constexpr int SC_XV = 131584, SC_XS = 133632;
__device__ __forceinline__ void scan_phase(const Params& p, LAS unsigned char* lds, int q, int wg, int tid) {
    if (wg >= 128) return;
    const int lane = tid & 63, fr = lane & 15, fq = lane >> 4, w = __builtin_amdgcn_readfirstlane(tid >> 6);
    const int xcd = wg & 7, jj = wg >> 3, bh = xcd * 2 + (jj >> 3), sl = jj & 7, dv0 = 16 * sl, b = bh >> 3, h = bh & 7;
    const bool helper = tid >= 256;
    const unsigned char* rec0 = p.ws + WS_PREP + (size_t)((q & 1) * 1024 + bh * 64) * CHUNK_ELEMS * 2;
#define SC_BAR() do { asm volatile("s_waitcnt lgkmcnt(0)" ::: "memory"); __builtin_amdgcn_s_barrier(); asm volatile("" ::: "memory"); } while (0)
    if (helper) {
        const int t = tid - 256, t7 = t & 127;
        const unsigned so = (unsigned)t * 16u, so14 = (unsigned)t7 * 16u;
        const int d0 = (t >> 4) * 272 + (t & 15) * 16, d1 = (t >> 3) * 144 + (t & 7) * 16, d14 = (t7 >> 3) * 144 + (t7 & 7) * 16;
        u32x4 R0[15], R1[15], R2[15];
#define SC_SRC(i) ((i) < 12 ? (i) * 4096 : (i) < 14 ? (i) * 4096 + 16384 : 49152 + dv0 * 128)
#define SC_DST(i) ((i) < 8 ? d0 + ((i) >> 2) * 17408 + ((i) & 3) * 4352 : (i) < 12 ? d1 + SC_KD + ((i) - 8) * 4608 : (i) < 14 ? d1 + SC_QK + ((i) - 12) * 4608 : d14 + SC_UT)
#define SC_LDH(R, c) do { const unsigned char* rp_ = rec0 + (size_t)(c) * (CHUNK_ELEMS * 2); _Pragma("unroll") for (int i = 0; i < 15; ++i) R[i] = *(const u32x4*)(rp_ + SC_SRC(i) + (i == 14 ? so14 : so)); } while (0)
#define SC_STH(R, bf) do { _Pragma("unroll") for (int i = 0; i < 15; ++i) *(LAS u32x4*)(lds + (bf) * SC_BUF + SC_DST(i)) = R[i]; } while (0)
        SC_LDH(R0, 0); SC_LDH(R1, 1); SC_LDH(R2, 2); SC_STH(R0, 0); SC_BAR();
#pragma unroll 1
        for (int n = 0; n < 60; n += 3) {
            SC_LDH(R0, n + 3); SC_STH(R1, (n + 1) & 1); SC_BAR(); SC_BAR();
            SC_LDH(R1, n + 4); SC_STH(R2, (n + 2) & 1); SC_BAR(); SC_BAR();
            SC_LDH(R2, n + 5); SC_STH(R0, (n + 3) & 1); SC_BAR(); SC_BAR();
        }
        SC_LDH(R0, 63); SC_STH(R1, 1); SC_BAR(); SC_BAR();
        SC_STH(R2, 0); SC_BAR(); SC_BAR();
        SC_STH(R0, 1); SC_BAR(); SC_BAR();
        SC_BAR(); SC_BAR();
#undef SC_LDH
#undef SC_STH
#undef SC_SRC
#undef SC_DST
    } else {
        f32x4* st = (f32x4*)(p.ws + WS_STATE) + (size_t)wg * 8 * 64 + lane;
        const float* GL = (const float*)(p.ws + WS_GL) + (q & 1) * 1024 + bh * 64;
        _Float16* O = (_Float16*)p.out;
        const float glr0 = GL[lane];
        f32x4 S0 = q ? st[(2 * w) * 64] : (f32x4){0.f, 0.f, 0.f, 0.f}, S1 = q ? st[(2 * w + 1) * 64] : (f32x4){0.f, 0.f, 0.f, 0.f};
        LAS unsigned char* XV = lds + SC_XV; LAS unsigned char* XS = lds + SC_XS;
        *(LAS bf16x8*)(XS + w * 1024 + lane * 16) = pack8(S0, S1);
        SC_BAR();
        const int aw = (16 * w + fr) * 272 + fq * 16, ak = (16 * w + fr) * 144 + fq * 16, akd = (32 * w + fr) * 144 + fq * 16;
#pragma unroll 1
        for (int n = 0; n < 64; ++n) {
            LAS unsigned char* B_ = lds + (n & 1) * SC_BUF;
            const float gl = __uint_as_float((unsigned)__builtin_amdgcn_readlane((int)__float_as_uint(glr0), n));
            bf16x8 Sb[4], Wf[4], QGf[4], QKf[2], KDf[2][2];
#pragma unroll
            for (int ks = 0; ks < 4; ++ks) { Sb[ks] = *(const LAS bf16x8*)(XS + ks * 1024 + lane * 16); Wf[ks] = *(const LAS bf16x8*)(B_ + SC_W + aw + ks * 64); }
            const u32x2 uw = *(const LAS u32x2*)(B_ + SC_UT + fr * 144 + w * 32 + fq * 8);
#pragma unroll
            for (int ks = 0; ks < 4; ++ks) QGf[ks] = *(const LAS bf16x8*)(B_ + SC_QG + aw + ks * 64);
            __builtin_amdgcn_sched_barrier(0);
#pragma unroll
            for (int k2 = 0; k2 < 2; ++k2) { QKf[k2] = *(const LAS bf16x8*)(B_ + SC_QK + ak + k2 * 64); KDf[0][k2] = *(const LAS bf16x8*)(B_ + SC_KD + akd + k2 * 64); KDf[1][k2] = *(const LAS bf16x8*)(B_ + SC_KD + akd + 2304 + k2 * 64); }
            f32x4 acc = {0.f, 0.f, 0.f, 0.f}, oa = {0.f, 0.f, 0.f, 0.f};
#pragma unroll
            for (int ks = 0; ks < 4; ++ks) { acc = MFMA16(Wf[ks], Sb[ks], acc); oa = MFMA16(QGf[ks], Sb[ks], oa); }
            const f32x4 vn = (f32x4){bflo(uw.x), bfhi(uw.x), bflo(uw.y), bfhi(uw.y)} - acc;
            { u32x2 pv = {cvtpk(vn[0], vn[1]), cvtpk(vn[2], vn[3])}; *(LAS u32x2*)(XV + (w >> 1) * 1024 + lane * 16 + (w & 1) * 8) = pv; }
            SC_BAR();
            bf16x8 Vb[2];
#pragma unroll
            for (int k2 = 0; k2 < 2; ++k2) Vb[k2] = *(const LAS bf16x8*)(XV + k2 * 1024 + lane * 16);
            S0 = S0 * gl; S1 = S1 * gl;
#pragma unroll
            for (int k2 = 0; k2 < 2; ++k2) { oa = MFMA16(QKf[k2], Vb[k2], oa); S0 = MFMA16(KDf[0][k2], Vb[k2], S0); S1 = MFMA16(KDf[1][k2], Vb[k2], S1); }
            *(LAS bf16x8*)(XS + w * 1024 + lane * 16) = pack8(S0, S1);
            { const size_t t0 = (size_t)b * SEQ + (size_t)(q * 64 + n) * 64; _Float16* op = O + (t0 + 16 * w + 4 * fq) * DM + h * 128 + dv0 + fr;
#pragma unroll
              for (int e = 0; e < 4; ++e) op[e * DM] = (_Float16)oa[e]; }
            SC_BAR();
        }
        if (q < 3) { st[(2 * w) * 64] = S0; st[(2 * w + 1) * 64] = S1; }
    }
#undef SC_BAR
}

__device__ __forceinline__ void attn_phase(const Params& p, char* lds, int wg, int G) {
    using bf = att::bf16;
    const bf* Qb = (const bf*)(p.ws + WS_BIG); const bf* Kb = (const bf*)(p.ws + WS_BIG + 64 * MiB); const bf* Vb = (const bf*)(p.ws + WS_BIG + 128 * MiB);
    bf* Ob = (bf*)(p.ws + WS_O);
    constexpr int TOTAL = 1024;
    auto mkref = [&](int L, int pass) {
        int hidx, x;
        if ((G & 7) == 0) { const int xcd = L & 7, k = L >> 3; hidx = (k >> 5) * 8 + xcd; x = k & 31; } else { hidx = L >> 5; x = L & 31; }
        const int qb = pass ? x : 63 - x,     bh = hidx >> 2, m = (hidx >> 1) & 1, vh = hidx & 1, b = bh >> 2, h = bh & 3;
        att::BlockRef<bf, bf> r;
        r.Q = Qb + ((size_t)(bh * 2 + m) * SEQ + (size_t)qb * 256) * 128; r.K = Kb + (size_t)(bh * 2 + m) * SEQ * 128; r.V = Vb + (size_t)(bh * 2 + vh) * SEQ * 128;
        r.O = Ob + ((size_t)m * TT + (size_t)b * SEQ + (size_t)qb * 256) * DM + h * 256 + vh * 128; r.P0 = qb * 256;
        return r; };
    int L = wg; if (L >= TOTAL) return;
    int pass = 0;
    att::BlockRef<bf, bf> cur = mkref(L, 0);
    att::Seam<bf> S;
    int Wv = 1 << 30, skv = SEQ; asm volatile("" : "+s"(Wv), "+s"(skv));
    att::causal_swa_prime<bf, bf>(cur, Wv, lds, S);
    for (;;) {
        const bool more_pass = pass == 0, more_item = L + G < TOTAL, last = !more_pass && !more_item;
        int passn = pass + 1, Ln = L;
        if (!more_pass) { passn = 0; Ln = more_item ? L + G : L; }
        const att::BlockRef<bf, bf> nxt = last ? cur : mkref(Ln, passn);
        att::causal_swa_block<bf, bf>(cur, nxt, skv, Wv, lds, S);
        if (last) break;
        cur = nxt; pass = passn; L = Ln;
    }
}

#define XB_TMO      128
#define XB_XCNT(j)  (256  + 64 * (j))
#define XB_XSUB(j)  (1280 + 64 * (j))
#define XB_XGEN(j)  (2304 + 64 * (j))
#define XB_TOP      3328
#define XB_TOPGEN   3392
#define XCD_BAR_WORDS 3456
#define XB_SPIN_CAP (1u << 18)

__device__ __forceinline__ unsigned xb_ld(unsigned* p)              { return __hip_atomic_load(p, __ATOMIC_RELAXED, __HIP_MEMORY_SCOPE_AGENT); }
__device__ __forceinline__ unsigned xb_add(unsigned* p, unsigned v) { return __hip_atomic_fetch_add(p, v, __ATOMIC_RELAXED, __HIP_MEMORY_SCOPE_AGENT); }
__device__ __forceinline__ unsigned xb_xcc_id() { return (unsigned)__builtin_amdgcn_s_getreg((3 << 11) | 20) & 0xFu; }
#define XB_SPIN(cond, bar) do { unsigned _sp = 0; while (cond) { __builtin_amdgcn_s_sleep(1); \
    if ((++_sp & 255u) == 0u) { if (xb_ld(&(bar)[XB_TMO])) break; if (_sp > XB_SPIN_CAP) { atomicAdd(&(bar)[XB_TMO], 1u); break; } } } } while (0)

struct XcdBarrier {
    unsigned* bar; unsigned x;
    volatile LAS unsigned* st;
};

__device__ __forceinline__ XcdBarrier xcd_barrier_post(unsigned* bar, volatile LAS unsigned* st) {
    XcdBarrier b; b.bar = bar; b.x = xb_xcc_id(); b.st = st;
    if (threadIdx.x == 0) (void)xb_add(&bar[XB_XCNT(b.x)], 1u);
    return b;
}
__device__ __forceinline__ void xcd_barrier_complete(unsigned* bar, unsigned x, unsigned& nloc, unsigned& nx) {
    const unsigned G = gridDim.x * gridDim.y * gridDim.z;
    unsigned sum, cnt, mine, sp = 0u;
    for (;;) {
        sum = 0u; cnt = 0u; mine = 0u;
#pragma unroll
        for (unsigned j = 0; j < 16; ++j) { const unsigned c = xb_ld(&bar[XB_XCNT(j)]); sum += c; cnt += (c > 0u) ? 1u : 0u; mine = (j == x) ? c : mine; }
        if (sum == G) break;
        __builtin_amdgcn_s_sleep(1);
        if ((++sp & 255u) == 0u) { if (xb_ld(&bar[XB_TMO])) break; if (sp > XB_SPIN_CAP) { atomicAdd(&bar[XB_TMO], 1u); break; } }
    }
    nloc = mine > 0u ? mine : 1u; nx = cnt > 0u ? cnt : 1u;
}

__device__ __forceinline__ void xcd_barrier(const XcdBarrier& b) {
    asm volatile("s_waitcnt vmcnt(0)" ::: "memory");
    __syncthreads();
    if (threadIdx.x == 0) {
        unsigned* bar = b.bar;
        __builtin_amdgcn_s_waitcnt(0);
        unsigned nloc = b.st[0], nx = b.st[1];
        if (nloc == 0u) { xcd_barrier_complete(bar, b.x, nloc, nx); b.st[0] = nloc; b.st[1] = nx; }
        const unsigned old = xb_add(&bar[XB_XSUB(b.x)], 1u);
        const unsigned gen = old / nloc;
        if (old + 1u == (gen + 1u) * nloc) {
            __builtin_amdgcn_fence(__ATOMIC_RELEASE, "agent");
            asm volatile("s_waitcnt vmcnt(0)" ::: "memory");
            const unsigned og = xb_add(&bar[XB_TOP], 1u);
            const unsigned tg = og / nx;
            if (og + 1u == (tg + 1u) * nx) xb_add(&bar[XB_TOPGEN], 1u);
            else XB_SPIN(xb_ld(&bar[XB_TOPGEN]) == tg, bar);
            __builtin_amdgcn_fence(__ATOMIC_ACQUIRE, "agent");
            xb_add(&bar[XB_XGEN(b.x)], 1u);
            asm volatile("s_waitcnt vmcnt(0)" ::: "memory");
        } else {
            XB_SPIN(xb_ld(&bar[XB_XGEN(b.x)]) == gen, bar);
            __builtin_amdgcn_fence(__ATOMIC_ACQUIRE, "agent");
            asm volatile("s_waitcnt vmcnt(0)" ::: "memory");
        }
    }
    __syncthreads();
}
constexpr size_t WS_BARW = 7 * MiB;
constexpr int LDS_BARST = 131072 + 64;
__device__ __forceinline__ Params load_params(const Params& p) {
#if defined(__HIP_DEVICE_COMPILE__)
    const __attribute__((address_space(4))) Params* pq = (const __attribute__((address_space(4))) Params*)__builtin_amdgcn_kernarg_segment_ptr();
    asm volatile("" : "+s"(pq)); Params q = *pq; return q;
#else
    return p;
#endif
}
__global__ void __launch_bounds__(512, 2) mega(Params p) {
    extern __shared__ __attribute__((aligned(16))) unsigned char lds_raw[];
    LAS unsigned char* lds = (LAS unsigned char*)lds_raw;
    const int tid0 = threadIdx.x, wg0 = blockIdx.x, G0 = gridDim.x, ph_lo = p.ph_lo, ph_hi = p.ph_hi;
    if (tid0 < 8) ((LAS unsigned*)(lds + LDS_BARST))[tid0] = 0u;
    __syncthreads();
    XcdBarrier bar; bar.bar = nullptr; bar.x = 0; bar.st = nullptr;
    if (ph_hi - ph_lo > 1) bar = xcd_barrier_post((unsigned*)(load_params(p).ws + WS_BARW), (volatile LAS unsigned*)(lds + LDS_BARST));
    if (ph_lo < -1000) cg::this_grid().sync();
#ifndef PHMASK
#define PHMASK 0xFFFFFFFFu
#endif
#define PHSEL(k) (1)
#ifndef REPMASK
#define REPMASK 0u
#endif
#define REPSEL(k) (0)
#define PH_BEGIN(k) if (PHSEL(k) && ph_lo <= (k) && (k) < ph_hi) for (int rep_ = 0; rep_ < 1 + REPSEL(k); ++rep_) { int tid = tid0, wg = wg0, G = G0; asm volatile("" : "+v"(tid), "+s"(wg), "+s"(G)); Params q = load_params(p); unsigned char* ws = q.ws; \
        float* modv = (float*)(ws + WS_MOD); float* kvmod = (float*)(ws + WS_KVMOD); bf16_t* HB = (bf16_t*)(ws + WS_HB); bf16_t* HB2 = (bf16_t*)(ws + WS_HB2); bf16_t* HB3 = (bf16_t*)(ws + WS_HB3); \
        bf16_t* BIG = (bf16_t*)(ws + WS_BIG); bf16_t* H0 = (bf16_t*)q.out; (void)modv; (void)kvmod; (void)HB; (void)HB2; (void)HB3; (void)BIG; (void)H0; (void)tid;
#define PH_END(k) } do { if (ph_lo <= (k) && (k) + 1 < ph_hi) { xcd_barrier(bar); } } while (0)
    PH_BEGIN(0) p0_prologue(q, lds, wg, G, tid); PH_END(0);
    PH_BEGIN(1) modulate_phase<true>(q, lds, q.in[0], q.in[4], modv + 0 * 1024, modv + 1 * 1024, 6144, H0, wg, G, tid); PH_END(1);
    PH_BEGIN(2) pg8::Gemm g{H0, (const bf16_t*)(ws + WS_WIN), TT, 4096, 1024}; pg8::StaticOrder S; S.init(TT, 4096, G, wg); pg8::EpiStoreBf16 E{BIG, 4096, 0};
            pg8::gemm_phase<pg8::EpiStoreBf16, pg8::StaticOrder, true, true>(lds, g, S, E); PH_END(2);
    PH_BEGIN(3) prep_phase(q, lds, 0, wg, G, (1024 - wg + G - 1) / G, tid); PH_END(3);
#define GDN_STAGE(ph, k) PH_BEGIN(ph) if (wg < 128) { scan_phase(q, lds, (k) - 1, wg, tid); __syncthreads(); } \
        if (G == 256) { if (wg < 128) prep_phase(q, lds, (k), 896 + wg, 1, 1, tid); else prep_phase(q, lds, (k), (wg - 128) * 7, 1, 7, tid); } \
        else prep_phase(q, lds, (k), wg, G, (1024 - wg + G - 1) / G, tid); PH_END(ph);
    GDN_STAGE(4, 1)
    GDN_STAGE(5, 2)
    GDN_STAGE(6, 3)
    PH_BEGIN(7) if (wg < 128) scan_phase(q, lds, 3, wg, tid); if (G <= 128) __syncthreads(); if (wg >= 128 || G <= 128) p0_weights(q, lds, 1, G <= 128 ? wg : wg - 128, G <= 128 ? G : G - 128, tid); PH_END(7);
    PH_BEGIN(8) gate_phase(q.out, BIG, q.in[10], HB, wg, G, tid); PH_END(8);
    PH_BEGIN(9) pg8::Gemm g{HB, (const bf16_t*)(ws + WS_WAO), TT, 1024, 1024}; pg8::StaticOrder S; S.init(TT, 1024, G, wg); pg8::EpiResid E{q.in[0], q.out, modv + 2 * 1024, 6144};
            pg8::gemm_phase<pg8::EpiResid, pg8::StaticOrder, true, true>(lds, g, S, E); PH_END(9);
#define MLP_PHASES(l, pb) \
    PH_BEGIN(pb) float* mv = modv + (l) * 2 * 6144; modulate_phase<false>(q, lds, q.out, q.in[5] + (l) * 1024, mv + 3 * 1024, mv + 4 * 1024, 6144, HB, wg, G, tid); PH_END(pb); \
    PH_BEGIN(pb + 1) pg8::Gemm g{HB, (const bf16_t*)(ws + WS_W1 + (size_t)(l) * 16 * MiB), TT, 4096, 1024}; pg8::StaticOrder S; S.init(TT, 4096, G, wg); pg8::EpiStoreBf16 E{BIG, 4096, 1}; \
            pg8::gemm_phase<pg8::EpiStoreBf16, pg8::StaticOrder, true, true>(lds, g, S, E); PH_END(pb + 1); \
    PH_BEGIN(pb + 2) float* mv = modv + (l) * 2 * 6144; pg8::Gemm g{BIG, (const bf16_t*)(ws + WS_W2 + (size_t)(l) * 16 * MiB), TT, 1024, 4096}; pg8::StaticOrder S; S.init(TT, 1024, G, wg); pg8::EpiResid E{q.out, q.out, mv + 5 * 1024, 6144}; \
            pg8::gemm_phase<pg8::EpiResid, pg8::StaticOrder, true, true>(lds, g, S, E); PH_END(pb + 2);
    MLP_PHASES(0, 10)
    PH_BEGIN(13) modulate2_phase(q.out, q.in[14], kvmod, kvmod + 1024, 2048, HB2, q.in[4] + 1024, modv + 2 * 6144, modv + 2 * 6144 + 1024, 6144, HB, wg, G, tid); PH_END(13);
    PH_BEGIN(14) const float* rc = (const float*)(ws + WS_ROPEC); const float* rs = (const float*)(ws + WS_ROPES);
        { pg8::Gemm g{HB2, (const bf16_t*)(ws + WS_WKV), TT, 2048, 1024}; pg8::StaticOrder S; S.init(TT, 2048, G, wg); pg8::EpiRope E{BIG + 32 * MiB, BIG + 64 * MiB, rc, rs, 4};
          pg8::gemm_phase<pg8::EpiRope, pg8::StaticOrder, true, true>(lds, g, S, E); }
        __syncthreads();
        { unsigned char* ws2 = ws; int wg2 = wg, G2 = G; asm volatile("" : "+s"(ws2), "+s"(wg2), "+s"(G2)); const float* rc2 = (const float*)(ws2 + WS_ROPEC); const float* rs2 = (const float*)(ws2 + WS_ROPES); bf16_t* Q2 = (bf16_t*)(ws2 + WS_BIG);
          pg8::Gemm g{(const bf16_t*)(ws2 + WS_HB), (const bf16_t*)(ws2 + WS_WQ), TT, 1024, 1024}; pg8::StaticOrder S; S.init(TT, 1024, G2, wg2); pg8::EpiRope E{Q2, Q2, rc2, rs2, 4};
          pg8::gemm_phase<pg8::EpiRope, pg8::StaticOrder, true, true>(lds, g, S, E); } PH_END(14);
    PH_BEGIN(15) attn_phase(q, (char*)lds_raw, wg, G); PH_END(15);
    PH_BEGIN(16) combine_phase(q, (const bf16_t*)(ws + WS_O), HB3, wg, G, tid); PH_END(16);
    PH_BEGIN(17) pg8::Gemm g{HB3, (const bf16_t*)(ws + WS_WBO), TT, 1024, 1024}; pg8::StaticOrder S; S.init(TT, 1024, G, wg); pg8::EpiResid E{q.out, q.out, modv + 2 * 6144 + 2 * 1024, 6144};
        pg8::gemm_phase<pg8::EpiResid, pg8::StaticOrder, true, true>(lds, g, S, E); PH_END(17);
    MLP_PHASES(1, 18)
    PH_BEGIN(21) final_phase(q.out, q.in[22], wg, G, tid); }
#undef PH_BEGIN
#undef PH_END
}

extern "C" void kernel_launch(void* const* d_in, const int* in_sizes, int n_in, void* d_out, int out_size, void* d_ws, size_t ws_size, hipStream_t stream) {
    static int grid = 0;
    if (grid == 0) {
        if (n_in != 23 || out_size != TT * DM || ws_size < WS_END) { fprintf(stderr, "kernel_launch: unexpected shapes n_in %d out %d ws %zu\n", n_in, out_size, ws_size); grid = -1; return; }
        int dev = 0, cus = 0, per_cu = 0;
        (void)hipGetDevice(&dev); (void)hipDeviceGetAttribute(&cus, hipDeviceAttributeMultiprocessorCount, dev);
        if (hipFuncSetAttribute((const void*)mega, hipFuncAttributeMaxDynamicSharedMemorySize, LDS_BYTES) != hipSuccess) { fprintf(stderr, "kernel_launch: hipFuncSetAttribute failed\n"); grid = -1; return; }
        if (hipOccupancyMaxActiveBlocksPerMultiprocessor(&per_cu, (const void*)mega, 512, LDS_BYTES) != hipSuccess || per_cu < 1) { fprintf(stderr, "kernel_launch: occupancy query says %d\n", per_cu); per_cu = 1; }
        (void)hipGetLastError();
        grid = cus * 1;
        if (grid <= 0) grid = 256;
    }
    if (grid < 0) return;
    Params p{};
    for (int i = 0; i < 23; ++i) p.in[i] = (const float*)d_in[i];
    p.out = (float*)d_out; p.ws = (unsigned char*)d_ws;
#if MK_SINGLE
    if (hipMemsetAsync((unsigned char*)d_ws + WS_BARW, 0, XCD_BAR_WORDS * 4, stream) != hipSuccess) { fprintf(stderr, "kernel_launch: memset of the barrier words failed\n"); return; }
    p.ph_lo = 0; p.ph_hi = NPH;
    void* args[] = {&p};
    hipError_t e = hipLaunchCooperativeKernel((const void*)mega, dim3(grid), dim3(512), args, LDS_BYTES, stream);
    if (e != hipSuccess) fprintf(stderr, "cooperative launch failed: %s (grid %d)\n", hipGetErrorString(e), grid);
#else
    for (int ph = 0; ph < NPH; ++ph) { p.ph_lo = ph; p.ph_hi = ph + 1; hipLaunchKernelGGL(mega, dim3(grid), dim3(512), LDS_BYTES, stream, p); }
#endif
}
```

```cpp
#include <hip/hip_runtime.h>
#include <hip/hip_bf16.h>
#include <hip/hip_cooperative_groups.h>
#include <cstdio>
#include <cstdint>
namespace cg = cooperative_groups;
#ifndef MK_SINGLE
#define MK_SINGLE 1
#endif
typedef _Float16 h16x8 __attribute__((ext_vector_type(8)));
typedef _Float16 h16x2 __attribute__((ext_vector_type(2)));
typedef float mf32x4 __attribute__((ext_vector_type(4)));
typedef float mf32x16 __attribute__((ext_vector_type(16)));
template <class A, class B> __device__ __forceinline__ mf32x4 MFMA16(A a, B b, mf32x4 c, int = 0, int = 0, int = 0) { return __builtin_amdgcn_mfma_f32_16x16x32_f16(__builtin_bit_cast(h16x8, a), __builtin_bit_cast(h16x8, b), c, 0, 0, 0); }
typedef __bf16 bf16x2_t __attribute__((ext_vector_type(2)));
typedef short sh16x8 __attribute__((ext_vector_type(8)));
template <class A, class B> __device__ __forceinline__ mf32x4 MFMA16B(A a, B b, mf32x4 c, int = 0, int = 0, int = 0) { return __builtin_amdgcn_mfma_f32_16x16x32_bf16(__builtin_bit_cast(sh16x8, a), __builtin_bit_cast(sh16x8, b), c, 0, 0, 0); }
template <class A, class B> __device__ __forceinline__ mf32x16 MFMA32B(A a, B b, mf32x16 c, int = 0, int = 0, int = 0) { return __builtin_amdgcn_mfma_f32_32x32x16_bf16(__builtin_bit_cast(sh16x8, a), __builtin_bit_cast(sh16x8, b), c, 0, 0, 0); }
__device__ __forceinline__ unsigned pkbf(float lo, float hi) { bf16x2_t v = {(__bf16)lo, (__bf16)hi}; return __builtin_bit_cast(unsigned, v); }
__device__ __forceinline__ unsigned pkf16(float lo, float hi) { h16x2 v = {(_Float16)lo, (_Float16)hi}; return __builtin_bit_cast(unsigned, v); }
template <class A, class B> __device__ __forceinline__ mf32x16 MFMA32(A a, B b, mf32x16 c, int = 0, int = 0, int = 0) { return __builtin_amdgcn_mfma_f32_32x32x16_f16(__builtin_bit_cast(h16x8, a), __builtin_bit_cast(h16x8, b), c, 0, 0, 0); }
namespace pg8 {
#define PG8_LAS __attribute__((address_space(3)))
typedef unsigned short bf16_t;
typedef short bf16x8 __attribute__((ext_vector_type(8)));
typedef float f32x4 __attribute__((ext_vector_type(4)));
typedef unsigned u32x4 __attribute__((ext_vector_type(4)));
constexpr int BM = 256, BK = 64, HALF = 128, HTB = HALF * BK * 2  , STAGE_BYTES = 8 * HTB, NXCD = 8, WGM = 8;

__host__ __device__ __forceinline__ int lds_byte(int r, int c) { const int st = (r >> 4) * 2 + (c >> 5), rr = r & 15, cc = c & 31, ob = rr * 64 + cc * 2; return st * 1024 + (ob ^ (((ob >> 9) & 1) << 5)); }
__host__ __device__ __forceinline__ void stage_rc(int b, int& R, int& C) { const int st = b / 1024, sb = b % 1024, swz = sb ^ (((sb >> 9) & 1) << 5); R = (st >> 1) * 16 + swz / 64; C = (st & 1) * 32 + (swz % 64) / 2; }
__host__ __device__ __forceinline__ int perm32(int rho) { const int n = rho >> 4, i = rho & 15; return 8 * (i >> 2) + 4 * n + (i & 3); }

struct Unit { int pm, pn; };
struct Gemm { const bf16_t* A; const bf16_t* Bt; int M, N, K; };

struct StaticOrder {
    int nM, nN, nwg, G, c;
    __host__ __device__ void init(int M, int N, int G_, int c_) { nM = M / BM; nN = N / BM; nwg = nM * nN; G = G_; c = c_; }
    __host__ __device__ bool next(int i, Unit& u) const {
        const long L = (long)i * G + c; if (L >= nwg) return false;
        int wgid = (int)L; { const int q = nwg / NXCD, r = nwg % NXCD, xcd = wgid % NXCD, off = wgid / NXCD; wgid = (xcd < r ? xcd * (q + 1) : r * (q + 1) + (xcd - r) * q) + off; }
        const int nig = WGM * nN, gid = wgid / nig, fm = gid * WGM, gsz = (nM - fm) < WGM ? (nM - fm) : WGM;
        u.pm = fm + ((wgid % nig) % gsz); u.pn = (wgid % nig) / gsz; return true;
    }
    __device__ __forceinline__ void a_ready(const Unit&) const {}
    __device__ __forceinline__ void done(const Unit&) const {}
};

__device__ __forceinline__ unsigned cvt_pk_bf16(float lo, float hi) { return pkbf(lo, hi); }
typedef float f32x2 __attribute__((ext_vector_type(2)));
__device__ __forceinline__ f32x2 gelu_pk(f32x2 v) {
    const f32x2 av = __builtin_elementwise_abs(v), d = av * 0.2316418882f + 1.0f;
    f32x2 t; t.x = __builtin_amdgcn_rcpf(d.x); t.y = __builtin_amdgcn_rcpf(d.y);
    f32x2 q = t * 0.5307027145f + (-0.7265760135f); q = q * t + 0.7107068705f; q = q * t + (-0.142248368f); q = q * t + 0.127414796f; q = q * t;
    const f32x2 s = (v * v) * (-0.72134752044f);
    f32x2 e; e.x = __builtin_amdgcn_exp2f(s.x); e.y = __builtin_amdgcn_exp2f(s.y);
    const f32x2 m = v * (q * e), r = v - m;
    f32x2 o; o.x = v.x < 0.f ? m.x : r.x; o.y = v.y < 0.f ? m.y : r.y; return o;
}

template <int ACT  > struct EpiBf16 {
    static constexpr bool PERM = true, AFTER_DRAIN = false; static_assert(ACT == 0 || ACT == 1, "EpiBf16: ACT is 0 (none) or 1 (gelu_pk)");
    bf16_t* O; int ldc; const float* bias; int split_cols; size_t split_stride; float scale0;
    __device__ __forceinline__ void operator()(const f32x4 (&acc)[2][2][4][2], const Unit& u, int wr, int wc, int fr, int fq) const {
        const int row0 = u.pm * BM + wr * 64 + fr; int colt = u.pn * BM; bf16_t* base = O;
        float sc = 1.f; if (split_cols) { const int t = colt / split_cols; base += (size_t)t * split_stride; colt -= t * split_cols; if (t == 0) sc = scale0; }
        const int col0 = colt + wc * 32 + 8 * fq, bcol0 = u.pn * BM + wc * 32 + 8 * fq;
        f32x4 bv[2][2];
#pragma unroll
        for (int bj = 0; bj < 2; ++bj)
#pragma unroll
            for (int n = 0; n < 2; ++n) bv[bj][n] = bias ? *(const f32x4*)(bias + bcol0 + bj * HALF + 4 * n) : (f32x4){0.f, 0.f, 0.f, 0.f};
#pragma unroll
        for (int ai = 0; ai < 2; ++ai)
#pragma unroll
            for (int m = 0; m < 4; ++m) { bf16_t* rowp = base + (size_t)(row0 + ai * HALF + m * 16) * ldc + col0;
#pragma unroll
                for (int bj = 0; bj < 2; ++bj) { f32x4 v0 = acc[ai][bj][m][0] + bv[bj][0], v1 = acc[ai][bj][m][1] + bv[bj][1];
                    if (ACT == 1) { f32x2 a = gelu_pk((f32x2){v0[0], v0[1]}), b = gelu_pk((f32x2){v0[2], v0[3]}), c = gelu_pk((f32x2){v1[0], v1[1]}), d = gelu_pk((f32x2){v1[2], v1[3]});
                        v0 = (f32x4){a.x, a.y, b.x, b.y}; v1 = (f32x4){c.x, c.y, d.x, d.y}; }
                    v0 = v0 * sc; v1 = v1 * sc; u32x4 w; w.x = cvt_pk_bf16(v0[0], v0[1]); w.y = cvt_pk_bf16(v0[2], v0[3]); w.z = cvt_pk_bf16(v1[0], v1[1]); w.w = cvt_pk_bf16(v1[2], v1[3]);
                    *(u32x4*)(rowp + bj * HALF) = w; } }
    }
};

template <class Epi, class Sched, bool ALIGN_EPI = false, bool SP2 = false>
__device__ __forceinline__ void gemm_phase(PG8_LAS unsigned char* lds, const Gemm g, const Sched& S, const Epi& E) {
    int tid = threadIdx.x; asm volatile("" : "+v"(tid));
    const int wid = __builtin_amdgcn_readfirstlane(tid >> 6), lane = tid & 63, wr = wid >> 2, wc = wid & 3, fr = lane & 15, fq = lane >> 4;
    const int K = g.K, nt = K / BK;
    unsigned voffA[2], voffB[2];
#pragma unroll
    for (int i = 0; i < 2; ++i) { int R, C; stage_rc(tid * 16 + i * 8192, R, C); const int Rb = Epi::PERM ? ((R & ~31) + perm32(R & 31)) : R;
        voffA[i] = (unsigned)(R * K + C) * 2u; voffB[i] = (unsigned)(Rb * K + C) * 2u; }
    const size_t kstep = (size_t)(BK * 2);
    const size_t hstep = (size_t)HALF * K * 2;
    const size_t tstep = 2 * hstep;
    const unsigned ldsw = (unsigned)wid * 1024u;
    const int aoff = lds_byte(wr * 64 + fr, fq * 8), boff = lds_byte(wc * 32 + fr, fq * 8);
#define PG8_SA(b, h) (((b) * 2 + (h)) * HTB)
#define PG8_SB(b, h) ((4 + (b) * 2 + (h)) * HTB)
#define PG8_STAGE(bufoff, gbase, voff) do { _Pragma("unroll") for (int _i = 0; _i < 2; ++_i) \
        __builtin_amdgcn_global_load_lds((const unsigned*)((const char*)(gbase) + (voff)[_i]), (PG8_LAS unsigned*)(lds + (bufoff) + ldsw + _i * 8192), 16, 0, 0); } while (0)
#define PG8_LDA(dst, b, h) do { _Pragma("unroll") for (int m = 0; m < 4; ++m) _Pragma("unroll") for (int k = 0; k < 2; ++k) dst[m][k] = *(const PG8_LAS bf16x8*)(lds + PG8_SA(b, h) + aoff + m * 2048 + k * 1024); } while (0)
#define PG8_LDB(dst, b, h) do { _Pragma("unroll") for (int n = 0; n < 2; ++n) _Pragma("unroll") for (int k = 0; k < 2; ++k) dst[n][k] = *(const PG8_LAS bf16x8*)(lds + PG8_SB(b, h) + boff + n * 2048 + k * 1024); } while (0)
#define PG8_MMA(ai, bj, At, Bt) do { __builtin_amdgcn_s_setprio(1); _Pragma("unroll") for (int m = 0; m < 4; ++m) _Pragma("unroll") for (int n = 0; n < 2; ++n) _Pragma("unroll") for (int k = 0; k < 2; ++k) \
        acc[ai][bj][m][n] = MFMA16B(Bt[n][k], At[m][k], acc[ai][bj][m][n], 0, 0, 0); __builtin_amdgcn_s_setprio(0); } while (0)
#define PG8_WAIT_V(n) asm volatile("s_waitcnt vmcnt(" #n ")" ::: "memory")
#define PG8_WAIT_L(n) asm volatile("s_waitcnt lgkmcnt(" #n ")" ::: "memory")
#define PG8_BAR __builtin_amdgcn_s_barrier()
#define PG8_SCHED __builtin_amdgcn_sched_barrier(0)
    Unit cur, nxt; int ui = 0;
    if (!S.next(0, cur)) return;
    f32x4 acc[2][2][4][2];
#pragma unroll
    for (int a = 0; a < 2; ++a)
#pragma unroll
        for (int b = 0; b < 2; ++b)
#pragma unroll
            for (int m = 0; m < 4; ++m)
#pragma unroll
                for (int n = 0; n < 2; ++n) acc[a][b][m][n] = (f32x4){0.f, 0.f, 0.f, 0.f};
    bf16x8 At[4][2], B0[2][2], B1[2][2];
    const char* cA = (const char*)g.A + (size_t)cur.pm * tstep; const char* cB = (const char*)g.Bt + (size_t)cur.pn * tstep;
    S.a_ready(cur);
    if constexpr (SP2) {
        PG8_STAGE(PG8_SB(0, 0), cB, voffB); PG8_STAGE(PG8_SB(0, 1), cB + hstep, voffB); PG8_STAGE(PG8_SA(0, 0), cA, voffA); PG8_STAGE(PG8_SA(0, 1), cA + hstep, voffA);
        if (wr == 1) PG8_BAR;
        PG8_WAIT_V(2); PG8_BAR;
        PG8_STAGE(PG8_SB(1, 0), cB + kstep, voffB); PG8_STAGE(PG8_SA(1, 0), cA + kstep, voffA); PG8_STAGE(PG8_SB(1, 1), cB + hstep + kstep, voffB);
        PG8_WAIT_V(6); PG8_BAR;
    } else {
        PG8_STAGE(PG8_SB(0, 0), cB, voffB); PG8_STAGE(PG8_SA(0, 0), cA, voffA); PG8_STAGE(PG8_SB(0, 1), cB + hstep, voffB); PG8_STAGE(PG8_SA(0, 1), cA + hstep, voffA);
        if (wr == 1) PG8_BAR;
        PG8_WAIT_V(4); PG8_BAR;
        PG8_STAGE(PG8_SB(1, 0), cB + kstep, voffB); PG8_STAGE(PG8_SA(1, 0), cA + kstep, voffA); PG8_STAGE(PG8_SB(1, 1), cB + hstep + kstep, voffB);
        PG8_WAIT_V(6); PG8_BAR;
    }
    for (;;) {
        const bool has_next = S.next(ui + 1, nxt);
        const char* nA = has_next ? (const char*)g.A + (size_t)nxt.pm * tstep : cA; const char* nB = has_next ? (const char*)g.Bt + (size_t)nxt.pn * tstep : cB;
        for (int t = 0; t < nt; t += 2) {
            const bool last = (t == nt - 2);
            const char* a1 = cA + (size_t)(t + 1) * kstep;
            const char* a2 = last ? nA : cA + (size_t)(t + 2) * kstep; const char* b2 = last ? nB : cB + (size_t)(t + 2) * kstep;
            const char* a3 = a2 + kstep; const char* b3 = b2 + kstep;
            if (last && has_next) S.a_ready(nxt);
            if constexpr (SP2) {
            PG8_LDB(B0, 0, 0); PG8_LDB(B1, 0, 1); PG8_SCHED; PG8_LDA(At, 0, 0); PG8_STAGE(PG8_SA(1, 1), a1 + hstep, voffA);
            PG8_WAIT_V(8); PG8_WAIT_L(0); PG8_BAR; PG8_MMA(0, 0, At, B0); PG8_MMA(0, 1, At, B1); PG8_BAR; PG8_SCHED;
            PG8_LDA(At, 0, 1); PG8_STAGE(PG8_SB(0, 0), b2, voffB); PG8_STAGE(PG8_SB(0, 1), b2 + hstep, voffB); PG8_STAGE(PG8_SA(0, 0), a2, voffA);
            PG8_WAIT_V(8); PG8_WAIT_L(0); PG8_BAR; PG8_MMA(1, 0, At, B0); PG8_MMA(1, 1, At, B1); PG8_BAR; PG8_SCHED;
            PG8_LDB(B0, 1, 0); PG8_LDB(B1, 1, 1); PG8_SCHED; PG8_LDA(At, 1, 0); PG8_STAGE(PG8_SA(0, 1), a2 + hstep, voffA);
            PG8_WAIT_V(8); PG8_WAIT_L(0); PG8_BAR; PG8_MMA(0, 0, At, B0); PG8_MMA(0, 1, At, B1); PG8_BAR; PG8_SCHED;
            PG8_LDA(At, 1, 1); PG8_STAGE(PG8_SB(1, 0), b3, voffB); PG8_STAGE(PG8_SB(1, 1), b3 + hstep, voffB); PG8_STAGE(PG8_SA(1, 0), a3, voffA);
            PG8_WAIT_V(8); PG8_WAIT_L(0); PG8_BAR; PG8_MMA(1, 0, At, B0); PG8_MMA(1, 1, At, B1); PG8_BAR; PG8_SCHED;
            } else {
            PG8_LDB(B0, 0, 0); PG8_SCHED; PG8_LDA(At, 0, 0); PG8_STAGE(PG8_SA(1, 1), a1 + hstep, voffA);
            PG8_WAIT_L(8); PG8_BAR; PG8_WAIT_L(0); PG8_MMA(0, 0, At, B0); PG8_BAR; PG8_SCHED;
            PG8_LDB(B1, 0, 1); PG8_STAGE(PG8_SB(0, 0), b2, voffB);
            PG8_BAR; PG8_WAIT_L(0); PG8_MMA(0, 1, At, B1); PG8_BAR;
            PG8_LDA(At, 0, 1); PG8_STAGE(PG8_SA(0, 0), a2, voffA);
            PG8_BAR; PG8_WAIT_L(0); PG8_MMA(1, 0, At, B0); PG8_BAR; PG8_SCHED;
            PG8_STAGE(PG8_SB(0, 1), b2 + hstep, voffB);
            PG8_WAIT_V(6); PG8_BAR; PG8_MMA(1, 1, At, B1); PG8_BAR;
            PG8_LDB(B0, 1, 0); PG8_SCHED; PG8_LDA(At, 1, 0); PG8_STAGE(PG8_SA(0, 1), a2 + hstep, voffA);
            PG8_WAIT_L(8); PG8_BAR; PG8_WAIT_L(0); PG8_MMA(0, 0, At, B0); PG8_BAR; PG8_SCHED;
            PG8_LDB(B1, 1, 1); PG8_STAGE(PG8_SB(1, 0), b3, voffB);
            PG8_BAR; PG8_WAIT_L(0); PG8_MMA(0, 1, At, B1); PG8_BAR;
            PG8_LDA(At, 1, 1); PG8_STAGE(PG8_SA(1, 0), a3, voffA);
            PG8_BAR; PG8_WAIT_L(0); PG8_MMA(1, 0, At, B0); PG8_BAR; PG8_SCHED;
            PG8_STAGE(PG8_SB(1, 1), b3 + hstep, voffB);
            PG8_WAIT_V(6); PG8_BAR; PG8_MMA(1, 1, At, B1); PG8_BAR;
            }
        }
        if constexpr (ALIGN_EPI) { if (wr == 0) PG8_BAR; }
        if constexpr (!Epi::AFTER_DRAIN) { E(acc, cur, wr, wc, fr, fq); S.done(cur); }
        if (!has_next) break;
#pragma unroll
        for (int a = 0; a < 2; ++a)
#pragma unroll
            for (int b = 0; b < 2; ++b)
#pragma unroll
                for (int m = 0; m < 4; ++m)
#pragma unroll
                    for (int n = 0; n < 2; ++n) acc[a][b][m][n] = (f32x4){0.f, 0.f, 0.f, 0.f};
        cur = nxt; cA = nA; cB = nB; ++ui;
        if constexpr (ALIGN_EPI) { if (wr == 1) PG8_BAR; }
    }
    PG8_WAIT_V(0);
    if constexpr (!ALIGN_EPI) { if (wr == 0) PG8_BAR; }
    PG8_BAR;
    if constexpr (Epi::AFTER_DRAIN) { E.fused(acc, cur, wr, wc, fr, fq, lds, wid, lane); S.done(cur); }
#undef PG8_SA
#undef PG8_SB
#undef PG8_STAGE
#undef PG8_LDA
#undef PG8_LDB
#undef PG8_MMA
#undef PG8_WAIT_V
#undef PG8_WAIT_L
#undef PG8_BAR
#undef PG8_SCHED
}
}
namespace pg8 {
typedef unsigned u32x2 __attribute__((ext_vector_type(2)));
struct EpiStoreBf16 {
    static constexpr bool PERM = true, AFTER_DRAIN = false;
    bf16_t* O; int ldc; int act; int f16out;
    __device__ __forceinline__ void operator()(const f32x4 (&acc)[2][2][4][2], const Unit& u, int wr, int wc, int fr, int fq) const {
        const int row0 = u.pm * BM + wr * 64 + fr; const int col0 = u.pn * BM + wc * 32 + 8 * fq;
#pragma unroll
        for (int ai = 0; ai < 2; ++ai)
#pragma unroll
            for (int m = 0; m < 4; ++m) { bf16_t* rowp = O + (size_t)(row0 + ai * HALF + m * 16) * ldc + col0;
#pragma unroll
                for (int bj = 0; bj < 2; ++bj) { f32x4 v0 = acc[ai][bj][m][0], v1 = acc[ai][bj][m][1];
                    if (act == 1) {
#pragma unroll
                        for (int e = 0; e < 4; ++e) { float a = fmaxf(v0[e], 0.f), b = fmaxf(v1[e], 0.f); v0[e] = a * a; v1[e] = b * b; } }
                    u32x4 w; if (f16out) { w.x = pkf16(v0[0], v0[1]); w.y = pkf16(v0[2], v0[3]); w.z = pkf16(v1[0], v1[1]); w.w = pkf16(v1[2], v1[3]); }
                    else { w.x = cvt_pk_bf16(v0[0], v0[1]); w.y = cvt_pk_bf16(v0[2], v0[3]); w.z = cvt_pk_bf16(v1[0], v1[1]); w.w = cvt_pk_bf16(v1[2], v1[3]); }
                    *(u32x4*)(rowp + bj * HALF) = w; } }
    }
};
struct EpiResid {
    static constexpr bool PERM = false, AFTER_DRAIN = false;
    const float* base; float* out; const float* gate; int gstride;
    __device__ __forceinline__ void operator()(const f32x4 (&acc)[2][2][4][2], const Unit& u, int wr, int wc, int fr, int fq) const {
        const int row0 = u.pm * BM + wr * 64 + fr; const int col0 = u.pn * BM + wc * 32 + 4 * fq;
        const float* gp = gate + (size_t)(u.pm >= 64 ? gstride : 0) + col0;
#pragma unroll
        for (int bj = 0; bj < 2; ++bj)
#pragma unroll
            for (int n = 0; n < 2; ++n) { const f32x4 gv = *(const f32x4*)(gp + bj * HALF + n * 16);
#pragma unroll
                for (int ai = 0; ai < 2; ++ai)
#pragma unroll
                    for (int m = 0; m < 4; ++m) { const size_t off = (size_t)(row0 + ai * HALF + m * 16) * 1024 + col0 + bj * HALF + n * 16;
                        const f32x4 bs = *(const f32x4*)(base + off); *(f32x4*)(out + off) = bs + gv * acc[ai][bj][m][n]; } }
    }
};
struct EpiRope {
    static constexpr bool PERM = false, AFTER_DRAIN = false;
    bf16_t* dstK; bf16_t* dstV; const float* cs; const float* sn; int nrope;
    __device__ __forceinline__ void operator()(const f32x4 (&acc)[2][2][4][2], const Unit& u, int wr, int wc, int fr_, int fq_) const {
        int fr = fr_, fq = fq_; asm volatile("" : "+v"(fr), "+v"(fq));
        const int b = u.pm >> 6, s0 = (u.pm & 63) * 256; const bool rope = u.pn < nrope; const int head = rope ? u.pn : u.pn - nrope;
        bf16_t* dst = rope ? dstK : dstV;
#pragma unroll
        for (int ai = 0; ai < 2; ++ai)
#pragma unroll
            for (int m = 0; m < 4; ++m) { const int srow = s0 + ai * HALF + wr * 64 + m * 16 + fr;
                f32x4 c4 = {1.f, 1.f, 1.f, 1.f}, s4 = {0.f, 0.f, 0.f, 0.f};
                if (rope && wc == 0) { c4 = *(const f32x4*)(cs + (size_t)srow * 16 + 4 * fq); s4 = *(const f32x4*)(sn + (size_t)srow * 16 + 4 * fq); }
#pragma unroll
                for (int bj = 0; bj < 2; ++bj) { bf16_t* bp = dst + ((size_t)((b * 4 + head) * 2 + bj) * 16384 + srow) * 128 + wc * 32 + 4 * fq;
                    f32x4 v0 = acc[ai][bj][m][0], v1 = acc[ai][bj][m][1];
                    if (rope && wc == 0) { const f32x4 o0 = v0 * c4 - v1 * s4, o1 = v1 * c4 + v0 * s4; v0 = o0; v1 = o1; }
                    u32x2 w0, w1; w0.x = cvt_pk_bf16(v0[0], v0[1]); w0.y = cvt_pk_bf16(v0[2], v0[3]); w1.x = cvt_pk_bf16(v1[0], v1[1]); w1.y = cvt_pk_bf16(v1[2], v1[3]);
                    *(u32x2*)bp = w0; *(u32x2*)(bp + 16) = w1; }
                asm volatile("" ::: "memory"); }
    }
};
}
namespace att {
constexpr int D = 128, OLD = 1024;
constexpr float THR = 8.f; constexpr bool WSKIP = false;
using bf16 = __hip_bfloat16;
typedef short bf16x8 __attribute__((ext_vector_type(8)));
typedef short s16x4 __attribute__((ext_vector_type(4)));
typedef float f32x16 __attribute__((ext_vector_type(16)));
typedef float f32x4 __attribute__((ext_vector_type(4)));
typedef unsigned u32x4 __attribute__((ext_vector_type(4)));
template <class A, class Bt> struct same_t { static constexpr bool v = false; };
template <class A> struct same_t<A, A> { static constexpr bool v = true; };
constexpr float SCALE = 0.08838834764831845f;
constexpr int NW = 8, QBLK = 32, KVBLK = 64, QB = NW * QBLK;
constexpr int SHM_V = KVBLK * D * 2, SHM_K = KVBLK * D * 2;
constexpr int ATT_LDS_BYTES = 2 * SHM_V + 2 * SHM_K + NW * 64 * 4;


#define KSWZ(row, colB) ((row) * 256 + ((colB) ^ (((row) & 7) << 4)))
#define SBAR() __builtin_amdgcn_sched_barrier(0)
__device__ __forceinline__ int v_st(int k, int c) { const int kk = (k & ~0xC) | ((k & 4) << 1) | ((k & 8) >> 1); return ((kk >> 3) * 4 + (c >> 5)) * 512 + ((kk & 7) * 32 + (c & 31)) * 2; }
__device__ __forceinline__ int v_rd_base(int lane) { return ((lane & 3) << 3) | (((lane >> 2) & 3) << 6) | (((lane >> 4) & 1) << 5) | (((lane >> 5) & 1) << 8); }
constexpr int v_rd_off(int d0, int ks, int half) { return d0 * 512 + ks * 4096 + half * 2048; }
__device__ __forceinline__ int crow(int r, int hi) { return (r & 3) + 8 * (r >> 2) + 4 * hi; }
__device__ __forceinline__ unsigned cvtpk(float lo, float hi) {
    unsigned r; asm volatile("v_cvt_pk_bf16_f32 %0, %1, %2" : "=v"(r) : "v"(lo), "v"(hi)); return r;
}
__device__ __forceinline__ bf16x8 pack8(f32x4 a, f32x4 b) {
    u32x4 w = {cvtpk(a[0], a[1]), cvtpk(a[2], a[3]), cvtpk(b[0], b[1]), cvtpk(b[2], b[3])};
    return *reinterpret_cast<bf16x8*>(&w);
}
template <class T> __device__ __forceinline__ bf16x8 load8(const T* p) {
    if constexpr (same_t<T, float>::v) { return pack8(*(const f32x4*)p, *(const f32x4*)(p + 4)); }
    else { return *reinterpret_cast<const bf16x8*>(p); }
}
__device__ __forceinline__ void mask_tile(f32x16& p0, f32x16& p1, int dq, unsigned W) {
    const float NEG = -__builtin_inff();
#pragma unroll
    for (int r = 0; r < 16; ++r) {
        const int c = (r & 3) + 8 * (r >> 2);
        if ((unsigned)(dq - c) >= W) p0[r] = NEG;
        if ((unsigned)(dq - c - 32) >= W) p1[r] = NEG;
    }
}
__device__ __forceinline__ void partialSM(f32x16& p0, f32x16& p1, float& m_reg, float& mn, float& alpha) {
    float pmax = p0[0]; for (int r = 1; r < 16; ++r) pmax = fmaxf(pmax, p0[r]); for (int r = 0; r < 16; ++r) pmax = fmaxf(pmax, p1[r]);
    { auto rr = __builtin_amdgcn_permlane32_swap(__float_as_uint(pmax), __float_as_uint(pmax), false, false);
      pmax = fmaxf(__uint_as_float(rr[0]), __uint_as_float(rr[1])); }
    constexpr float C2 = 1.4426950408889634f * SCALE;
    if (__builtin_expect(__all((pmax - m_reg) * SCALE <= THR), 1)) { mn = m_reg; alpha = 1.f; }
    else { mn = fmaxf(m_reg, pmax); alpha = __builtin_amdgcn_exp2f((m_reg - mn) * C2); m_reg = mn; }
    const float mnL = -mn * C2;
    for (int r = 0; r < 16; ++r) p0[r] = fmaf(p0[r], C2, mnL); for (int r = 0; r < 16; ++r) p1[r] = fmaf(p1[r], C2, mnL);
    for (int r = 0; r < 16; ++r) p0[r] = __builtin_amdgcn_exp2f(p0[r]);
}
__device__ __forceinline__ void finishSM(f32x16& p0, f32x16& p1, float alpha, float& l_reg, bf16x8& pa0, bf16x8& pa1, bf16x8& pa2, bf16x8& pa3) {
    for (int r = 0; r < 16; ++r) p1[r] = __builtin_amdgcn_exp2f(p1[r]);
    float ps = 0; for (int r = 0; r < 16; ++r) ps += p0[r]; for (int r = 0; r < 16; ++r) ps += p1[r];
    { auto rr = __builtin_amdgcn_permlane32_swap(__float_as_uint(ps), __float_as_uint(ps), false, false);
      ps = __uint_as_float(rr[0]) + __uint_as_float(rr[1]); }
    l_reg = l_reg * alpha + ps;
#define PK4(P, B_, OUT) do { unsigned a0 = cvtpk(P[B_+0], P[B_+1]), a1 = cvtpk(P[B_+2], P[B_+3]);                          \
        unsigned b0 = cvtpk(P[B_+4], P[B_+5]), b1 = cvtpk(P[B_+6], P[B_+7]);                                             \
        auto r0 = __builtin_amdgcn_permlane32_swap(a0, b0, false, false); auto r1 = __builtin_amdgcn_permlane32_swap(a1, b1, false, false); \
        u32x4 w = {r0[0], r1[0], r0[1], r1[1]}; OUT = *reinterpret_cast<bf16x8*>(&w); } while (0)
    PK4(p0, 0, pa0); PK4(p0, 8, pa1); PK4(p1, 0, pa2); PK4(p1, 8, pa3);
#undef PK4
}
template <int KB, bool SK>
__device__ __forceinline__ void qkt(f32x16& p0, f32x16& p1, const char* K_lds, int r32, int hi, const bf16x8* qr, bool act) {
    if (SK && !act) { const float NEG = -__builtin_inff();
#pragma unroll
        for (int r = 0; r < 16; ++r) { p0[r] = NEG; p1[r] = NEG; } return; }
    p0 = f32x16{}; p1 = f32x16{};
    const char* kb[4];
#pragma unroll
    for (int dd = 0; dd < 4; ++dd) kb[dd] = K_lds + KB * SHM_K + KSWZ(r32, (dd * 16 + hi * 8) * 2);
#pragma unroll
    for (int d0 = 0; d0 < 8; ++d0) { const char* a = kb[d0 & 3] + (d0 >> 2) * 128;
        bf16x8 b0 = *reinterpret_cast<const bf16x8*>(a);
        bf16x8 b1 = *reinterpret_cast<const bf16x8*>(a + 32 * 256);
        p0 = MFMA32B(b0, qr[d0], p0, 0, 0, 0);
        p1 = MFMA32B(b1, qr[d0], p1, 0, 0, 0); }
}
template <int VB, bool SK>
__device__ __forceinline__ void pv_tile(f32x16* o, int vb0, bf16x8 pa0, bf16x8 pa1, bf16x8 pa2, bf16x8 pa3, bool act) {
    if (SK && !act) return;
#define TRRD(dst, off) asm volatile("ds_read_b64_tr_b16 %0, %1 offset:%2" : "=&v"(dst) : "v"(vb0), "i"(off) : "memory")
#define PV_D0(d0) do { s16x4 l0, l1, l2, l3, h0, h1, h2, h3; constexpr int b_ = VB * SHM_V + v_rd_off(d0, 0, 0);     \
        TRRD(l0, b_); TRRD(h0, b_ + 2048); TRRD(l1, b_ + 4096); TRRD(h1, b_ + 6144); TRRD(l2, b_ + 8192); TRRD(h2, b_ + 10240); TRRD(l3, b_ + 12288); TRRD(h3, b_ + 14336); \
        asm volatile("s_waitcnt lgkmcnt(0)" ::: "memory"); SBAR();                 \
        o[d0] = MFMA32B(pa0, (bf16x8){l0[0], l0[1], l0[2], l0[3], h0[0], h0[1], h0[2], h0[3]}, o[d0], 0, 0, 0);   \
        o[d0] = MFMA32B(pa1, (bf16x8){l1[0], l1[1], l1[2], l1[3], h1[0], h1[1], h1[2], h1[3]}, o[d0], 0, 0, 0);   \
        o[d0] = MFMA32B(pa2, (bf16x8){l2[0], l2[1], l2[2], l2[3], h2[0], h2[1], h2[2], h2[3]}, o[d0], 0, 0, 0);   \
        o[d0] = MFMA32B(pa3, (bf16x8){l3[0], l3[1], l3[2], l3[3], h3[0], h3[1], h3[2], h3[3]}, o[d0], 0, 0, 0); } while (0)
    PV_D0(0); PV_D0(1); PV_D0(2); PV_D0(3);
#undef PV_D0
#undef TRRD
}

template <class TIn, class TOut> struct BlockRef { const TIn* Q; const TIn* K; const TIn* V; TOut* O; int P0; };
template <class TIn> struct Seam {
    bf16x8 qr[8];
    bf16x8 st_v0, st_v1, st_k0, st_k1; f32x4 sf0, sf1, sf2, sf3;
    f32x4 tq[16];
};
__device__ __forceinline__ int swa_jlo(int P0, int W) { const int lowk = P0 - W + 1; return lowk > 0 ? lowk / KVBLK : 0; }
#define ROW(p, k0, rr) ((p) + (size_t)((k0) + (rr)) * D + sc)
#define VMW() asm volatile("s_waitcnt vmcnt(0)" ::: "memory")
#define VMWN(n) asm volatile("s_waitcnt vmcnt(%0)" :: "i"(n) : "memory")
#define SLOAD_H(Kp, Vp, k0) do { S.st_v0 = load8<TIn>(ROW(Vp, k0, sr)); S.st_v1 = load8<TIn>(ROW(Vp, k0, 32 + sr));              \
                         S.st_k0 = load8<TIn>(ROW(Kp, k0, sr)); S.st_k1 = load8<TIn>(ROW(Kp, k0, 32 + sr)); } while (0)
#define SWRITE_HK(bf) do { *(bf16x8*)(K_lds + (bf) * SHM_K + kws) = S.st_k0; *(bf16x8*)(K_lds + (bf) * SHM_K + kws + 32 * 256) = S.st_k1; } while (0)
#define SWRITE_HV(bf) do { *(bf16x8*)(V_lds + (bf) * SHM_V + vst0) = S.st_v0; *(bf16x8*)(V_lds + (bf) * SHM_V + vst1) = S.st_v1; } while (0)
#define SWRITE_H(bf) do { SWRITE_HV(bf); SWRITE_HK(bf); } while (0)
#define SLOAD_F(p, k0) do { S.sf0 = *(const f32x4*)ROW(p, k0, sr); S.sf1 = *(const f32x4*)(ROW(p, k0, sr) + 4);                \
                            S.sf2 = *(const f32x4*)ROW(p, k0, 32 + sr); S.sf3 = *(const f32x4*)(ROW(p, k0, 32 + sr) + 4); } while (0)
#define SWRITE_KF(bf) do { *(bf16x8*)(K_lds + (bf) * SHM_K + kws) = pack8(S.sf0, S.sf1); *(bf16x8*)(K_lds + (bf) * SHM_K + kws + 32 * 256) = pack8(S.sf2, S.sf3); } while (0)
#define SWRITE_VF(bf) do { *(bf16x8*)(V_lds + (bf) * SHM_V + vst0) = pack8(S.sf0, S.sf1); *(bf16x8*)(V_lds + (bf) * SHM_V + vst1) = pack8(S.sf2, S.sf3); } while (0)
template <class TIn, class TOut>
__device__ __forceinline__ void causal_swa_prime(const BlockRef<TIn, TOut>& cur, int W, char* lds, Seam<TIn>& S) {
    constexpr bool F32 = same_t<TIn, float>::v;
    const int tid = threadIdx.x, wid = __builtin_amdgcn_readfirstlane(tid >> 6), lane = tid & 63, r32 = lane & 31, hi = lane >> 5;
    const int sr = tid >> 4, sc = (tid & 15) * 8, kws = KSWZ(sr, sc * 2); char* K_lds = lds + 2 * SHM_V;
    const int kb0 = swa_jlo(cur.P0, W) * KVBLK;
    for (int d0 = 0; d0 < 8; ++d0) S.qr[d0] = load8<TIn>(cur.Q + (size_t)(wid * QBLK + r32) * D + d0 * 16 + hi * 8);
    if constexpr (F32) { SLOAD_F((const float*)cur.K, kb0); VMW(); SWRITE_KF(0); SBAR(); SLOAD_F((const float*)cur.V, kb0); }
    else { SLOAD_H(cur.K, cur.V, kb0); VMW(); SWRITE_HK(0); }
    __syncthreads();
}
template <class TIn, class TOut>
__device__ __forceinline__ void causal_swa_block(const BlockRef<TIn, TOut>& cur, const BlockRef<TIn, TOut>& nxt, int skv, int W, char* lds, Seam<TIn>& S) {
    constexpr bool F32 = same_t<TIn, float>::v;
    const int tid = threadIdx.x, wid = __builtin_amdgcn_readfirstlane(tid >> 6), lane = tid & 63, r32 = lane & 31, hi = lane >> 5;
    const int j_lo = swa_jlo(cur.P0, W);
    int j_hi = (cur.P0 + QB - 1) / KVBLK + 1; if (j_hi > skv / KVBLK) j_hi = skv / KVBLK;
    const int NT = j_hi - j_lo;
    const int kbn = swa_jlo(nxt.P0, W) * KVBLK;
    const int qlo = cur.P0 + wid * QBLK, qm = qlo + r32 - 4 * hi;
    char* V_lds = lds; char* K_lds = lds + 2 * SHM_V;
    float* ws = (float*)(lds + 2 * SHM_V + 2 * SHM_K) + wid * 64; float* li_l = ws, * al_l = ws + 32;
    float m_reg = -1e30f, l_reg = 0; f32x16 o[4] = {};
    const int sr = tid >> 4, sc = (tid & 15) * 8, vst0 = v_st(sr, sc), vst1 = v_st(32 + sr, sc), kws = KSWZ(sr, sc * 2);
    const int vb0 = (int)(uintptr_t)V_lds + v_rd_base(lane);
    const TIn* Kh = cur.K; const TIn* Vh = cur.V;
#define RESC(a) do { if (__any((a) < 1.f)) { if (hi == 0) al_l[r32] = (a); asm volatile("s_waitcnt lgkmcnt(0)" ::: "memory");              \
                     for (int d_ = 0; d_ < 4; ++d_) for (int r = 0; r < 16; ++r) o[d_][r] *= al_l[crow(r, hi)]; } } while (0)
#define KBASE(t) ((j_lo + (t)) * KVBLK)
#define ACT(t) (KBASE(t) <= qlo + QBLK - 1 && KBASE(t) + KVBLK - 1 >= qlo - W + 1)
#define MASKT(P0_, P1_, t) do { const int kb_ = KBASE(t); if ((!SK || ACT(t)) && (kb_ + KVBLK - 1 > qlo || kb_ <= qlo + QBLK - 1 - W)) mask_tile(P0_, P1_, qm - kb_, (unsigned)W); } while (0)
    constexpr int NQL = F32 ? 16 : 8;
    constexpr bool SK = WSKIP && !F32;
#define SEAM_K0() do { VMWN(NQL); if constexpr (F32) { SWRITE_KF(0); SBAR(); SLOAD_F((const float*)nxt.V, kbn); } else { SWRITE_HK(0); } SBAR(); } while (0)
    f32x16 pA0, pA1, pB0, pB1; float mnA, mnB, alA, alB; bf16x8 pa0, pa1, pa2, pa3;
    if constexpr (F32) { VMW(); SWRITE_VF(0); SBAR(); } else { SWRITE_HV(0); SBAR(); }
    if (NT > 1) { if constexpr (F32) SLOAD_F((const float*)Kh, KBASE(1)); else SLOAD_H(Kh, Vh, KBASE(1)); }
    SBAR(); qkt<0, SK>(pA0, pA1, K_lds, r32, hi, S.qr, ACT(0));
    if constexpr (F32) { if (NT > 1) { VMW(); SWRITE_KF(1); SBAR(); SLOAD_F((const float*)Vh, KBASE(1)); } }
    MASKT(pA0, pA1, 0); partialSM(pA0, pA1, m_reg, mnA, alA);
    if (NT > 1) { VMW(); if constexpr (F32) { SWRITE_VF(1); SBAR(); if (NT > 2) SLOAD_F((const float*)Kh, KBASE(2)); } else SWRITE_H(1); }
    __syncthreads();
#define HALF_STEP(PX0, PX1, mnX, alX, PY0, PY1, alY, t, KB, VB, SB) do {                                                      \
        SBAR(); qkt<KB, SK>(PX0, PX1, K_lds, r32, hi, S.qr, ACT(t));                                             \
        finishSM(PY0, PY1, alY, l_reg, pa0, pa1, pa2, pa3); SBAR();                                                           \
        if ((t) + 1 < NT) { if constexpr (F32) { VMW(); SWRITE_KF(SB); SBAR(); SLOAD_F((const float*)Vh, KBASE((t) + 1)); }  \
                            else { SLOAD_H(Kh, Vh, KBASE((t) + 1)); } SBAR(); }                                               \
        pv_tile<VB, SK>(o, vb0, pa0, pa1, pa2, pa3, ACT((t) - 1)); MASKT(PX0, PX1, (t)); partialSM(PX0, PX1, m_reg, mnX, alX);                                        \
        __syncthreads();                                                                                                      \
        if ((t) + 1 < NT) { VMW(); if constexpr (F32) { SWRITE_VF(SB); SBAR(); if ((t) + 2 < NT) SLOAD_F((const float*)Kh, KBASE((t) + 2)); } \
                            else { SWRITE_H(SB); } }                                                                          \
        RESC(alX); __syncthreads(); } while (0)
    for (int t = 1; t + 1 < NT; t += 2) {
        HALF_STEP(pB0, pB1, mnB, alB, pA0, pA1, alA, t, 1, 0, 0);
        HALF_STEP(pA0, pA1, mnA, alA, pB0, pB1, alB, t + 1, 0, 1, 1);
    }
    const bool even = (NT & 1) == 0;
    if (even) { SBAR(); qkt<1, SK>(pB0, pB1, K_lds, r32, hi, S.qr, ACT(NT - 1)); SBAR(); }
#define QROW(e) (nxt.Q + (size_t)(wid * QBLK + r32) * D + ((e) >> 1) * 16 + hi * 8 + ((e) & 1) * 4)
    if constexpr (F32) { SLOAD_F((const float*)nxt.K, kbn); SBAR();
#pragma unroll
        for (int e = 0; e < 8; ++e) S.tq[e] = *(const f32x4*)QROW(e); }
    else { SLOAD_H(nxt.K, nxt.V, kbn); SBAR();
#pragma unroll
        for (int d0 = 0; d0 < 8; ++d0) S.qr[d0] = load8<TIn>(nxt.Q + (size_t)(wid * QBLK + r32) * D + d0 * 16 + hi * 8); }
    SBAR();
    finishSM(pA0, pA1, alA, l_reg, pa0, pa1, pa2, pa3); SBAR();
    if constexpr (F32) {
#pragma unroll
        for (int e = 8; e < 16; ++e) S.tq[e] = *(const f32x4*)QROW(e); SBAR(); }
#undef QROW
    pv_tile<0, SK>(o, vb0, pa0, pa1, pa2, pa3, ACT(even ? NT - 2 : NT - 1));
    if (even) { MASKT(pB0, pB1, NT - 1); partialSM(pB0, pB1, m_reg, mnB, alB); __syncthreads(); RESC(alB);
        finishSM(pB0, pB1, alB, l_reg, pa0, pa1, pa2, pa3); SBAR(); pv_tile<1, SK>(o, vb0, pa0, pa1, pa2, pa3, ACT(NT - 1)); }
    SBAR(); SEAM_K0();
    if (hi == 0) li_l[r32] = l_reg; asm volatile("s_waitcnt lgkmcnt(0)" ::: "memory");
    float rli[16];
#pragma unroll
    for (int r = 0; r < 16; ++r) rli[r] = __builtin_amdgcn_rcpf(li_l[crow(r, hi)]);
    TOut* Ow = cur.O + (size_t)(wid * QBLK) * OLD;
#pragma unroll
    for (int r = 0; r < 16; ++r) { const int orow = crow(r, hi);
#pragma unroll
        for (int d0 = 0; d0 < 4; ++d0) { const float v = o[d0][r] * rli[r];
            if constexpr (same_t<TOut, float>::v) { Ow[(size_t)orow * OLD + d0 * 32 + r32] = v; }
            else { const float vn = __shfl_xor(v, 1);
                   if ((r32 & 1) == 0) *(unsigned*)(Ow + (size_t)orow * OLD + d0 * 32 + r32) = cvtpk(v, vn); } } }
    if constexpr (F32) {
#pragma unroll
        for (int d0 = 0; d0 < 8; ++d0) S.qr[d0] = pack8(S.tq[2 * d0], S.tq[2 * d0 + 1]); }
    __syncthreads();
#undef RESC
#undef KBASE
#undef ACT
#undef MASKT
#undef SEAM_K0
#undef HALF_STEP
}
#undef ROW
#undef VMW
#undef VMWN
#undef SLOAD_H
#undef SWRITE_HK
#undef SWRITE_HV
#undef SWRITE_H
#undef SLOAD_F
#undef SWRITE_KF
#undef SWRITE_VF

}
#define LAS __attribute__((address_space(3)))
typedef unsigned short bf16_t;
typedef float f32x4 __attribute__((ext_vector_type(4)));
typedef float f32x2 __attribute__((ext_vector_type(2)));
typedef short bf16x8 __attribute__((ext_vector_type(8)));
typedef unsigned u32x4 __attribute__((ext_vector_type(4)));
typedef unsigned u32x2 __attribute__((ext_vector_type(2)));
constexpr int SEQ = 16384, DM = 1024, TT = 2 * SEQ, FF = 4096, NPH = 22;
constexpr size_t MiB = 1u << 20;
constexpr size_t WS_MOD = 0, WS_KVMOD = 128 * 1024, WS_ROPEC = 1 * MiB, WS_ROPES = 2 * MiB, WS_G = 3 * MiB, WS_BETA = 4 * MiB, WS_STATE = 5 * MiB, WS_GL = 6 * MiB;
constexpr size_t WS_WIN = 16 * MiB, WS_WAO = 24 * MiB, WS_WKV = 26 * MiB, WS_WQ = 30 * MiB, WS_WBO = 32 * MiB, WS_W1 = 34 * MiB, WS_W2 = 42 * MiB;
constexpr size_t WS_HB = 66 * MiB, WS_HB2 = 130 * MiB, WS_PREP = 66 * MiB, WS_O = 66 * MiB, WS_BIG = 256 * MiB, WS_HB3 = 448 * MiB, WS_END = 512 * MiB;
constexpr size_t CHUNK_ELEMS = 36864;
constexpr int LDS_BYTES = 147456;
constexpr float EPSN = 1e-6f;

__device__ __forceinline__ unsigned cvtpk(float lo, float hi) { h16x2 v = {(_Float16)lo, (_Float16)hi}; return __builtin_bit_cast(unsigned, v); }
__device__ __forceinline__ float bblo(unsigned w) { return __uint_as_float(w << 16); }
__device__ __forceinline__ float bbhi(unsigned w) { return __uint_as_float(w & 0xffff0000u); }
__device__ __forceinline__ float bflo(unsigned w) { return (float)__builtin_bit_cast(h16x2, w)[0]; }
__device__ __forceinline__ float bfhi(unsigned w) { return (float)__builtin_bit_cast(h16x2, w)[1]; }
__device__ __forceinline__ float wave_sum(float v) {
#pragma unroll
    for (int o = 1; o < 64; o <<= 1) v += __shfl_xor(v, o);
    return v;
}
__device__ __forceinline__ float siluf(float y) { return y * __builtin_amdgcn_rcpf(1.f + __expf(-y)); }
__device__ __forceinline__ bf16x8 pack8(f32x4 a, f32x4 b) { u32x4 w = {cvtpk(a[0], a[1]), cvtpk(a[2], a[3]), cvtpk(b[0], b[1]), cvtpk(b[2], b[3])}; return *reinterpret_cast<bf16x8*>(&w); }

struct Params { const float* in[23]; float* out; unsigned char* ws; int ph_lo, ph_hi; };

__device__ __forceinline__ void p0_transpose_item(const float* W, int K, int N, int ldw, bf16_t* WT, LAS float* scr, int item, int lane) {
    const int nblk = N / 32, kb = item / nblk, nb = item % nblk, k0 = 64 * kb, n0 = 32 * nb;
#pragma unroll 8
    for (int i = 0; i < 32; ++i) { const int kk = 2 * i + (lane >> 5); scr[kk * 33 + (lane & 31)] = W[(size_t)(k0 + kk) * ldw + n0 + (lane & 31)]; }
    asm volatile("s_waitcnt lgkmcnt(0)" ::: "memory");
    const int c = lane & 7;
#pragma unroll
    for (int j = 0; j < 4; ++j) { const int n = (lane >> 3) + 8 * j; const LAS float* s = scr + (8 * c) * 33 + n;
        u32x4 o; o.x = pkbf(s[0 * 33], s[1 * 33]); o.y = pkbf(s[2 * 33], s[3 * 33]); o.z = pkbf(s[4 * 33], s[5 * 33]); o.w = pkbf(s[6 * 33], s[7 * 33]);
        *(u32x4*)(WT + (size_t)(n0 + n) * K + k0 + 8 * c) = o; }
    asm volatile("s_waitcnt lgkmcnt(0)" ::: "memory");
}

__device__ __forceinline__ void p0_weights(const Params& p, LAS unsigned char* lds, int part, int wgr, int Gr, int tid) {
    const int wave = tid >> 6, lane = tid & 63;
    unsigned char* ws = p.ws;
    {
        LAS float* scr = (LAS float*)(lds + wave * 16384);
        const int gw = wgr * 8 + wave, NGW = Gr * 8;
        constexpr int I_IN = 16 * 128, I_SQ = 16 * 32, I_KV = 16 * 64, I_1 = 16 * 128, I_2 = 64 * 32;
        constexpr int NITEMS = I_IN + 3 * I_SQ + I_KV + 2 * I_1 + 2 * I_2;
        for (int it = (part ? I_IN : 0) + gw; it < (part ? NITEMS : I_IN); it += NGW) {
            int r = it;
            if (r < I_IN) { p0_transpose_item(p.in[6], 1024, 4096, 4112, (bf16_t*)(ws + WS_WIN), scr, r, lane); continue; } r -= I_IN;
            if (r < I_SQ) { p0_transpose_item(p.in[11], 1024, 1024, 1024, (bf16_t*)(ws + WS_WAO), scr, r, lane); continue; } r -= I_SQ;
            if (r < I_KV) { p0_transpose_item(p.in[15], 1024, 2048, 2048, (bf16_t*)(ws + WS_WKV), scr, r, lane); continue; } r -= I_KV;
            if (r < I_SQ) { p0_transpose_item(p.in[16], 1024, 1024, 1024, (bf16_t*)(ws + WS_WQ), scr, r, lane); continue; } r -= I_SQ;
            if (r < I_SQ) { p0_transpose_item(p.in[19], 1024, 1024, 1024, (bf16_t*)(ws + WS_WBO), scr, r, lane); continue; } r -= I_SQ;
            if (r < I_1) { p0_transpose_item(p.in[20], 1024, 4096, 4096, (bf16_t*)(ws + WS_W1), scr, r, lane); continue; } r -= I_1;
            if (r < I_1) { p0_transpose_item(p.in[20] + (size_t)1024 * 4096, 1024, 4096, 4096, (bf16_t*)(ws + WS_W1 + 16 * MiB), scr, r, lane); continue; } r -= I_1;
            if (r < I_2) { p0_transpose_item(p.in[21], 4096, 1024, 1024, (bf16_t*)(ws + WS_W2), scr, r, lane); continue; } r -= I_2;
            p0_transpose_item(p.in[21] + (size_t)4096 * 1024, 4096, 1024, 1024, (bf16_t*)(ws + WS_W2 + 16 * MiB), scr, r, lane);
        }
    }
}
__device__ __forceinline__ void p0_prologue(const Params& p, LAS unsigned char* lds, int wg, int G, int tid) {
    const int wave = tid >> 6, lane = tid & 63;
    unsigned char* ws = p.ws;
    p0_weights(p, lds, 0, wg, G, tid);
    __syncthreads();
    {
        float* rc = (float*)(ws + WS_ROPEC); float* rs = (float*)(ws + WS_ROPES);
        for (int idx = wg * 512 + tid; idx < SEQ * 16; idx += G * 512) {
            const int pos = idx >> 4, i = idx & 15;
            const double invf = exp(-(double)i * (1.0 / 16.0) * 13.122363377404328);
            const double rev = (double)pos * invf * 0.15915494309189535; const float fr = (float)(rev - floor(rev));
            rc[idx] = __builtin_amdgcn_cosf(fr); rs[idx] = __builtin_amdgcn_sinf(fr);
        }
    }
    {
        LAS float* cs = (LAS float*)lds;
        LAS float* part = (LAS float*)(lds + 8192);
        for (int i = tid; i < 2048; i += 512) cs[i] = siluf(p.in[1][i]);
        __syncthreads();
        for (int cb = wg; cb < 224; cb += G) {
            const float* W; int ld, n0; const float* bias; float* outp; int ostride;
            if (cb < 192) { const int l = cb / 96; n0 = (cb % 96) * 64; W = p.in[2] + (size_t)l * 1024 * 6144; ld = 6144; bias = p.in[3] + l * 6144; outp = (float*)(ws + WS_MOD) + l * 2 * 6144; ostride = 6144; }
            else { n0 = (cb - 192) * 64; W = p.in[12]; ld = 2048; bias = p.in[13]; outp = (float*)(ws + WS_KVMOD); ostride = 2048; }
            float a0 = 0.f, a1 = 0.f;
#pragma unroll 8
            for (int k = wave * 128; k < wave * 128 + 128; ++k) { const float w = W[(size_t)k * ld + n0 + lane]; a0 += cs[k] * w; a1 += cs[1024 + k] * w; }
            part[(wave * 2 + 0) * 64 + lane] = a0; part[(wave * 2 + 1) * 64 + lane] = a1;
            __syncthreads();
            if (tid < 128) { const int b = tid >> 6, c = tid & 63; float s = 0.f;
#pragma unroll
                for (int w = 0; w < 8; ++w) s += part[(w * 2 + b) * 64 + c];
                outp[b * ostride + n0 + c] = s + bias[n0 + c]; }
            __syncthreads();
        }
    }
}

__device__ __forceinline__ float reduce16_to_lane(const float (&acc)[16], int lane) {
    float r[8], s4[4], t2[2];
#pragma unroll
    for (int i = 0; i < 8; ++i) { const bool hi = lane & 1; const float keep = hi ? acc[2 * i + 1] : acc[2 * i], send = hi ? acc[2 * i] : acc[2 * i + 1]; r[i] = keep + __shfl_xor(send, 1); }
#pragma unroll
    for (int i = 0; i < 4; ++i) { const bool hi = lane & 2; const float keep = hi ? r[2 * i + 1] : r[2 * i], send = hi ? r[2 * i] : r[2 * i + 1]; s4[i] = keep + __shfl_xor(send, 2); }
#pragma unroll
    for (int i = 0; i < 2; ++i) { const bool hi = lane & 4; const float keep = hi ? s4[2 * i + 1] : s4[2 * i], send = hi ? s4[2 * i] : s4[2 * i + 1]; t2[i] = keep + __shfl_xor(send, 4); }
    const bool hi = lane & 8; float u = (hi ? t2[1] : t2[0]) + __shfl_xor(hi ? t2[0] : t2[1], 8);
    u += __shfl_xor(u, 16); u += __shfl_xor(u, 32);
    return u;
}
template <bool AB>
__device__ __forceinline__ void modulate_phase(const Params& p, LAS unsigned char* lds, const float* src, const float* g, const float* shift, const float* scale, int bstride,
                                               bf16_t* dst, int wg, int G, int tid) {
    const int wave = tid >> 6, lane = tid & 63, gw = wg * 8 + wave, NGW = G * 8;
    LAS float* wab = (LAS float*)lds;
    if (AB) {
        const float* win = p.in[6];
        for (int idx = tid; idx < 16384; idx += 512) { const int k = idx >> 4, c = idx & 15; wab[c * 1024 + k] = win[(size_t)k * 4112 + 4096 + c]; }
        __syncthreads();
    }
    for (int b = 0; b < 2; ++b) {
        f32x4 gs[4], sh[4];
#pragma unroll
        for (int j = 0; j < 4; ++j) { const int c = 4 * lane + 256 * j; const f32x4 gv = *(const f32x4*)(g + c), sc = *(const f32x4*)(scale + b * bstride + c); gs[j] = gv * (sc + 1.f); sh[j] = *(const f32x4*)(shift + b * bstride + c); }
        for (int m = b * SEQ + gw; m < (b + 1) * SEQ; m += 2 * NGW) {
            const int m1 = (m + NGW < (b + 1) * SEQ) ? m + NGW : m;
            const f32x4* xr0 = (const f32x4*)(src + (size_t)m * DM) + lane; const f32x4* xr1 = (const f32x4*)(src + (size_t)m1 * DM) + lane;
            f32x4 v0[4], v1[4]; float s0 = 0.f, s1 = 0.f;
#pragma unroll
            for (int j = 0; j < 4; ++j) { v0[j] = xr0[64 * j]; v1[j] = xr1[64 * j]; }
#pragma unroll
            for (int j = 0; j < 4; ++j) { s0 += (v0[j].x * v0[j].x + v0[j].y * v0[j].y) + (v0[j].z * v0[j].z + v0[j].w * v0[j].w); s1 += (v1[j].x * v1[j].x + v1[j].y * v1[j].y) + (v1[j].z * v1[j].z + v1[j].w * v1[j].w); }
            const float rstd0 = rsqrtf(wave_sum(s0) * (1.f / DM) + EPSN), rstd1 = rsqrtf(wave_sum(s1) * (1.f / DM) + EPSN);
            u32x2* o0 = (u32x2*)(dst + (size_t)m * DM) + lane; u32x2* o1 = (u32x2*)(dst + (size_t)m1 * DM) + lane;
#pragma unroll
            for (int j = 0; j < 4; ++j) { v0[j] = v0[j] * rstd0 * gs[j] + sh[j]; v1[j] = v1[j] * rstd1 * gs[j] + sh[j];
                u32x2 w; w.x = pkbf(v0[j].x, v0[j].y); w.y = pkbf(v0[j].z, v0[j].w); o0[64 * j] = w; w.x = pkbf(v1[j].x, v1[j].y); w.y = pkbf(v1[j].z, v1[j].w); o1[64 * j] = w; }
            if (AB) {
                asm volatile("" ::: "memory");
                float acc0[16], acc1[16];
#pragma unroll
                for (int c = 0; c < 16; ++c) { float a0 = 0.f, a1 = 0.f;
#pragma unroll
                    for (int j = 0; j < 4; ++j) { const f32x4 w = *(const LAS f32x4*)(wab + c * 1024 + 4 * lane + 256 * j);
                        a0 += (v0[j].x * w.x + v0[j].y * w.y) + (v0[j].z * w.z + v0[j].w * w.w); a1 += (v1[j].x * w.x + v1[j].y * w.y) + (v1[j].z * w.z + v1[j].w * w.w); }
                    acc0[c] = a0; acc1[c] = a1; }
                const float u0 = reduce16_to_lane(acc0, lane), u1 = reduce16_to_lane(acc1, lane);
                if (lane < 16) { const int hl = lane & 7;
                    if (lane < 8) { const float al = -expf(p.in[8][hl]), db = p.in[9][hl];
                        const float x0 = u0 + db, x1 = u1 + db;
                        ((float*)(p.ws + WS_G))[(size_t)m * 8 + hl] = al * (fmaxf(x0, 0.f) + log1pf(expf(-fabsf(x0))));
                        ((float*)(p.ws + WS_G))[(size_t)m1 * 8 + hl] = al * (fmaxf(x1, 0.f) + log1pf(expf(-fabsf(x1))));
                    } else {
                        ((float*)(p.ws + WS_BETA))[(size_t)m * 8 + hl] = 1.f / (1.f + expf(-u0));
                        ((float*)(p.ws + WS_BETA))[(size_t)m1 * 8 + hl] = 1.f / (1.f + expf(-u1));
                    } }
            }
        }
    }
}
__device__ __forceinline__ void modulate2_phase(const float* src, const float* g1, const float* shift1, const float* scale1, int bs1, bf16_t* dst1,
                                                const float* g2, const float* shift2, const float* scale2, int bs2, bf16_t* dst2, int wg, int G, int tid) {
    const int wave = tid >> 6, lane = tid & 63, gw = wg * 8 + wave, NGW = G * 8;
    for (int b = 0; b < 2; ++b) {
        f32x4 gs1[4], sh1[4], gs2[4], sh2[4];
#pragma unroll
        for (int j = 0; j < 4; ++j) { const int c = 4 * lane + 256 * j;
            gs1[j] = *(const f32x4*)(g1 + c) * (*(const f32x4*)(scale1 + b * bs1 + c) + 1.f); sh1[j] = *(const f32x4*)(shift1 + b * bs1 + c);
            gs2[j] = *(const f32x4*)(g2 + c) * (*(const f32x4*)(scale2 + b * bs2 + c) + 1.f); sh2[j] = *(const f32x4*)(shift2 + b * bs2 + c); }
        for (int m = b * SEQ + gw; m < (b + 1) * SEQ; m += NGW) {
            const f32x4* xr = (const f32x4*)(src + (size_t)m * DM) + lane;
            f32x4 v[4]; float s = 0.f;
#pragma unroll
            for (int j = 0; j < 4; ++j) { v[j] = xr[64 * j]; s += (v[j].x * v[j].x + v[j].y * v[j].y) + (v[j].z * v[j].z + v[j].w * v[j].w); }
            const float rstd = rsqrtf(wave_sum(s) * (1.f / DM) + EPSN);
            u32x2* o1 = (u32x2*)(dst1 + (size_t)m * DM) + lane; u32x2* o2 = (u32x2*)(dst2 + (size_t)m * DM) + lane;
#pragma unroll
            for (int j = 0; j < 4; ++j) { const f32x4 xn = v[j] * rstd; const f32x4 a = xn * gs1[j] + sh1[j], c2 = xn * gs2[j] + sh2[j];
                u32x2 w; w.x = pkbf(a.x, a.y); w.y = pkbf(a.z, a.w); o1[64 * j] = w; w.x = pkbf(c2.x, c2.y); w.y = pkbf(c2.z, c2.w); o2[64 * j] = w; }
        }
    }
}
__device__ __forceinline__ void gate_phase(const float* o, const bf16_t* proj, const float* outg, bf16_t* dst, int wg, int G, int tid) {
    const int wave = tid >> 6, lane = tid & 63, gw = wg * 8 + wave, NGW = G * 8;
    const f32x4 gv = *(const f32x4*)(outg + ((4 * lane) & 127));
    for (int m = gw; m < TT; m += NGW) {
        const f32x4* xr = (const f32x4*)(o + (size_t)m * DM) + lane; const u32x2* zr = (const u32x2*)(proj + (size_t)m * 4096 + 3072) + lane;
        u32x2* o8 = (u32x2*)(dst + (size_t)m * DM) + lane;
#pragma unroll
        for (int j = 0; j < 4; ++j) { const f32x4 v = xr[64 * j]; const u32x2 zz = zr[64 * j];
            float s = (v.x * v.x + v.y * v.y) + (v.z * v.z + v.w * v.w);
#pragma unroll
            for (int ofs = 1; ofs < 32; ofs <<= 1) s += __shfl_xor(s, ofs);
            const float rstd = rsqrtf(s * (1.f / 128.f) + EPSN);
            const f32x4 r = v * rstd * gv;
            u32x2 w; w.x = pkbf(r.x * siluf(bflo(zz.x)), r.y * siluf(bfhi(zz.x))); w.y = pkbf(r.z * siluf(bflo(zz.y)), r.w * siluf(bfhi(zz.y))); o8[64 * j] = w; }
    }
}
__device__ __forceinline__ void combine_phase(const Params& p, const bf16_t* O, bf16_t* dst, int wg, int G, int tid) {
    const int wave = tid >> 6, lane = tid & 63, gw = wg * 8 + wave, NGW = G * 8;
    const float lam_init = 0.8f - 0.6f * 0.7408182206817179f;
    const float* lp = p.in[17];
    float d1 = lp[lane] * lp[128 + lane] + lp[64 + lane] * lp[192 + lane], d2 = lp[256 + lane] * lp[384 + lane] + lp[320 + lane] * lp[448 + lane];
    const float lam = expf(wave_sum(d1)) - expf(wave_sum(d2)) + lam_init;
    const f32x4 gv = *(const f32x4*)(p.in[18] + 4 * lane) * (1.f - lam_init);
    for (int m = gw; m < TT; m += NGW) {
        const u32x2* a = (const u32x2*)(O + (size_t)m * DM) + lane; const u32x2* b = (const u32x2*)(O + (size_t)(TT + m) * DM) + lane;
        u32x2* o8 = (u32x2*)(dst + (size_t)m * DM) + lane;
#pragma unroll
        for (int j = 0; j < 4; ++j) { const u32x2 x1 = a[64 * j], x2 = b[64 * j];
            f32x4 v = {bblo(x1.x) - lam * bblo(x2.x), bbhi(x1.x) - lam * bbhi(x2.x), bblo(x1.y) - lam * bblo(x2.y), bbhi(x1.y) - lam * bbhi(x2.y)};
            const float s = wave_sum((v.x * v.x + v.y * v.y) + (v.z * v.z + v.w * v.w));
            const float rstd = rsqrtf(s * (1.f / 256.f) + EPSN);
            v = v * rstd * gv; u32x2 w; w.x = pkbf(v.x, v.y); w.y = pkbf(v.z, v.w); o8[64 * j] = w; }
    }
}
__device__ __forceinline__ void final_phase(float* x, const float* g, int wg, int G, int tid) {
    const int wave = tid >> 6, lane = tid & 63, gw = wg * 8 + wave, NGW = G * 8;
    f32x4 gs[4];
#pragma unroll
    for (int j = 0; j < 4; ++j) gs[j] = *(const f32x4*)(g + 4 * lane + 256 * j);
    for (int m = gw; m < TT; m += NGW) {
        f32x4* xr = (f32x4*)(x + (size_t)m * DM) + lane; f32x4 v[4]; float s = 0.f;
#pragma unroll
        for (int j = 0; j < 4; ++j) { v[j] = xr[64 * j]; s += (v[j].x * v[j].x + v[j].y * v[j].y) + (v[j].z * v[j].z + v[j].w * v[j].w); }
        const float rstd = rsqrtf(wave_sum(s) * (1.f / DM) + EPSN);
#pragma unroll
        for (int j = 0; j < 4; ++j) xr[64 * j] = v[j] * rstd * gs[j];
    }
}

template <int J> __device__ __forceinline__ void solve_load(f32x4 (&a)[16], const LAS float* AT) {
#pragma unroll
    for (int ib = (J + 1) / 4; ib < 16; ++ib) a[ib] = *(const LAS f32x4*)(AT + J * 68 + 4 * ib);
}
template <int J> __device__ __forceinline__ void solve_step(float (&x)[64], const f32x4 (&cur)[16], const LAS float* AT) {
    if constexpr (J < 63) {
        f32x4 nxt[16];
        if constexpr (J + 1 < 63) solve_load<J + 1>(nxt, AT);
#pragma unroll
        for (int ib = (J + 1) / 4; ib < 16; ++ib) {
#pragma unroll
            for (int e = 0; e < 4; ++e) { if (4 * ib + e > J) x[4 * ib + e] -= cur[ib][e] * x[J]; } }
        __builtin_amdgcn_sched_barrier(0);
        solve_step<J + 1>(x, nxt, AT);
    }
}
template <int J0, int J1> __device__ __forceinline__ void solve_range(float (&x)[64], const LAS float* AT) {
    f32x4 cur[16]; solve_load<J0>(cur, AT); solve_step<J0>(x, cur, AT);
}
constexpr int L_AT = 0, L_QS = 17408, L_KN = 34816, L_KF = 52224, L_VF = 84992, L_GC = 117760, L_BT = 118016, L_EG = 118272;
__device__ __forceinline__ void prep_phase(const Params& p, LAS unsigned char* lds, int q, int ufirst, int ustride, int ucnt, int tid_in) {
    const bf16_t* proj = (const bf16_t*)(p.ws + WS_BIG); const float* convw = p.in[7];
    const float* Gp = (const float*)(p.ws + WS_G); const float* Bp = (const float*)(p.ws + WS_BETA);
    LAS bf16_t* QS = (LAS bf16_t*)(lds + L_QS); LAS bf16_t* KN = (LAS bf16_t*)(lds + L_KN);
    LAS float* KF = (LAS float*)(lds + L_KF); LAS float* VF = (LAS float*)(lds + L_VF); LAS float* AT = (LAS float*)(lds + L_AT);
    LAS float* GC = (LAS float*)(lds + L_GC); LAS float* BT = (LAS float*)(lds + L_BT); LAS float* EG = (LAS float*)(lds + L_EG);
#pragma unroll 1
    for (int ui = 0; ui < ucnt; ++ui) { const int u = ufirst + ui * ustride;
        const int bh = u >> 6, nl = u & 63, b = bh >> 3, h = bh & 7, ng = q * 64 + nl;
        const size_t tb = (size_t)b * SEQ + (size_t)ng * 64;
        bf16_t* cb = (bf16_t*)(p.ws + WS_PREP) + (size_t)((q & 1) * 1024 + u) * CHUNK_ELEMS;
        int tid = tid_in; asm volatile("" : "+v"(tid));
        if (tid < 64) { const int lane = tid;
            float gv = Gp[(tb + lane) * 8 + h];
#pragma unroll
            for (int d = 1; d < 64; d <<= 1) { const float t = __shfl_up(gv, d); if (lane >= d) gv += t; }
            GC[lane] = gv; BT[lane] = Bp[(tb + lane) * 8 + h]; EG[lane] = __expf(gv);
            if (lane == 63) ((float*)(p.ws + WS_GL))[(q & 1) * 1024 + u] = __expf(gv);
        }
        __syncthreads();
        if (tid < 384) {
            const int cgi = tid % 48, rs = tid / 48, mat = cgi >> 4, c0 = (cgi & 15) * 8, r0 = rs * 8;
            const int ch = mat * 1024 + h * 128 + c0;
            float val[8][8];
            {
                f32x4 w[4][2];
#pragma unroll
                for (int j = 0; j < 4; ++j) { w[j][0] = *(const f32x4*)(convw + j * 3072 + ch); w[j][1] = *(const f32x4*)(convw + j * 3072 + ch + 4); }
                u32x4 raw[11];
#pragma unroll
                for (int rr = 0; rr < 11; ++rr) { const int sq = ng * 64 + r0 - 3 + rr; const bool ok = sq >= 0;
                    const bf16_t* sp = proj + ((size_t)b * SEQ + (ok ? sq : 0)) * 4096 + ch; u32x4 t = *(const u32x4*)sp; if (!ok) t = (u32x4){0u, 0u, 0u, 0u}; raw[rr] = t; }
#pragma unroll
                for (int r = 0; r < 8; ++r) { float ss = 0.f;
#pragma unroll
                    for (int e = 0; e < 8; ++e) { float a = 0.f;
#pragma unroll
                        for (int j = 0; j < 4; ++j) { const unsigned wd = raw[r + j][e >> 1]; const float xv = (e & 1) ? bfhi(wd) : bflo(wd); a += w[j][e >> 2][e & 3] * xv; }
                        const float y = siluf(a); val[r][e] = y; ss += y * y; }
                    ss += __shfl_xor(ss, 1); ss += __shfl_xor(ss, 2); ss += __shfl_xor(ss, 4); ss += __shfl_xor(ss, 8);
                    const float rstd = (mat < 2) ? rsqrtf(ss + EPSN) : 1.f;
#pragma unroll
                    for (int e = 0; e < 8; ++e) val[r][e] *= rstd; }
            }
            const float glast = GC[63];
#pragma unroll
            for (int r = 0; r < 8; ++r) { const int row = r0 + r;
                if (mat == 0) { const float eg = EG[row];
                    float q[8];
#pragma unroll
                    for (int e = 0; e < 8; ++e) q[e] = val[r][e] * 0.08838834764831845f;
                    u32x4 w = {cvtpk(q[0], q[1]), cvtpk(q[2], q[3]), cvtpk(q[4], q[5]), cvtpk(q[6], q[7])};
                    *(LAS u32x4*)(QS + row * 136 + c0) = w;
                    const int kb = c0 >> 5, j0 = c0 & 31, hi = j0 >> 4, q4 = (j0 & 15) >> 2;
                    bf16_t* d = cb + 8192 + row * 128 + 32 * kb + 8 * q4 + 4 * hi;
                    u32x2 g0 = {cvtpk(q[0] * eg, q[1] * eg), cvtpk(q[2] * eg, q[3] * eg)}, g1 = {cvtpk(q[4] * eg, q[5] * eg), cvtpk(q[6] * eg, q[7] * eg)};
                    *(u32x2*)d = g0; *(u32x2*)(d + 8) = g1;
                } else if (mat == 1) { const float be = BT[row] * EG[row]; const float kd = __expf(glast - GC[row]);
                    float k[8];
#pragma unroll
                    for (int e = 0; e < 8; ++e) { k[e] = val[r][e]; val[r][e] = k[e] * kd; }
                    u32x4 w = {cvtpk(k[0], k[1]), cvtpk(k[2], k[3]), cvtpk(k[4], k[5]), cvtpk(k[6], k[7])};
                    *(LAS u32x4*)(KN + row * 136 + c0) = w;
                    *(LAS f32x4*)(KF + row * 128 + c0) = (f32x4){k[0] * be, k[1] * be, k[2] * be, k[3] * be};
                    *(LAS f32x4*)(KF + row * 128 + c0 + 4) = (f32x4){k[4] * be, k[5] * be, k[6] * be, k[7] * be};
                } else { const float bt = BT[row];
                    *(LAS f32x4*)(VF + row * 128 + c0) = (f32x4){val[r][0] * bt, val[r][1] * bt, val[r][2] * bt, val[r][3] * bt};
                    *(LAS f32x4*)(VF + row * 128 + c0 + 4) = (f32x4){val[r][4] * bt, val[r][5] * bt, val[r][6] * bt, val[r][7] * bt};
                } }
            if (mat == 1) {
                const int jb = r0 >> 5, j0 = r0 & 31, hi = j0 >> 4, q4 = (j0 & 15) >> 2;
#pragma unroll
                for (int e = 0; e < 8; ++e) { bf16_t* d = cb + 16384 + (c0 + e) * 64 + 32 * jb + 8 * q4 + 4 * hi;
                    u32x2 a0 = {cvtpk(val[0][e], val[1][e]), cvtpk(val[2][e], val[3][e])}, a1 = {cvtpk(val[4][e], val[5][e]), cvtpk(val[6][e], val[7][e])};
                    *(u32x2*)d = a0; *(u32x2*)(d + 8) = a1; }
            }
        }
        __syncthreads();
        asm volatile("" : "+v"(tid));
        {
            const int fr = tid & 15, fq = (tid >> 4) & 3, wave = __builtin_amdgcn_readfirstlane(tid >> 6);
#pragma unroll
            for (int tt = 0; tt < 2; ++tt) { const int tile = wave * 2 + tt, mt = tile >> 2, nt = tile & 3;
                if (mt >= nt) {
                    f32x4 acc = {0.f, 0.f, 0.f, 0.f};
#pragma unroll
                    for (int ks = 0; ks < 4; ++ks) { const bf16x8 a = *(const LAS bf16x8*)(KN + (16 * mt + fr) * 136 + 32 * ks + 8 * fq), bb = *(const LAS bf16x8*)(KN + (16 * nt + fr) * 136 + 32 * ks + 8 * fq);
                        acc = MFMA16(a, bb, acc, 0, 0, 0); }
                    const int j = 16 * nt + fr; const float gj = GC[j]; f32x4 o;
#pragma unroll
                    for (int e = 0; e < 4; ++e) { const int i = 16 * mt + 4 * fq + e; o[e] = (i > j) ? BT[i] * acc[e] * __expf(GC[i] - gj) : 0.f; }
                    *(LAS f32x4*)(AT + j * 68 + 16 * mt + 4 * fq) = o;
                }
                u32x2 w = {0u, 0u};
                const int i = 16 * nt + fr;
                if (nt >= mt) {
                    f32x4 acc = {0.f, 0.f, 0.f, 0.f};
#pragma unroll
                    for (int ks = 0; ks < 4; ++ks) { const bf16x8 a = *(const LAS bf16x8*)(KN + (16 * mt + fr) * 136 + 32 * ks + 8 * fq), bb = *(const LAS bf16x8*)(QS + (16 * nt + fr) * 136 + 32 * ks + 8 * fq);
                        acc = MFMA16(a, bb, acc, 0, 0, 0); }
                    const float gi = GC[i]; float o[4];
#pragma unroll
                    for (int e = 0; e < 4; ++e) { const int j = 16 * mt + 4 * fq + e; o[e] = (i >= j) ? acc[e] * __expf(gi - GC[j]) : 0.f; }
                    w.x = cvtpk(o[0], o[1]); w.y = cvtpk(o[2], o[3]);
                }
                *(u32x2*)(cb + 32768 + i * 64 + 32 * (mt >> 1) + 8 * fq + 4 * (mt & 1)) = w;
            }
        }
        __syncthreads();
        asm volatile("" : "+v"(tid));
        if (tid < 256) {
            LAS float* MF = (tid < 128) ? (VF + tid) : (KF + (tid - 128));
            float x[64];
#pragma unroll
            for (int r = 0; r < 64; ++r) x[r] = MF[r * 128];
            solve_range<0, 63>(x, AT);
#pragma unroll
            for (int r = 0; r < 64; ++r) MF[r * 128] = x[r];
        }
        __syncthreads();
        asm volatile("" : "+v"(tid));
        { const int dv = tid & 127, rseg = tid >> 7; float uu[16];
#pragma unroll
            for (int r = 0; r < 16; ++r) uu[r] = VF[(16 * rseg + r) * 128 + dv];
            u32x4 w0 = {cvtpk(uu[0], uu[1]), cvtpk(uu[2], uu[3]), cvtpk(uu[4], uu[5]), cvtpk(uu[6], uu[7])}, w1 = {cvtpk(uu[8], uu[9]), cvtpk(uu[10], uu[11]), cvtpk(uu[12], uu[13]), cvtpk(uu[14], uu[15])};
            bf16_t* d = cb + 24576 + dv * 64 + 16 * rseg; *(u32x4*)d = w0; *(u32x4*)(d + 8) = w1; }
        { const int r = tid >> 3, cgp = tid & 7, kb = cgp >> 1, hi = cgp & 1;
#pragma unroll
            for (int g = 0; g < 4; ++g) { const f32x4 v = *(const LAS f32x4*)(KF + r * 128 + 16 * cgp + 4 * g); u32x2 w = {cvtpk(v.x, v.y), cvtpk(v.z, v.w)};
                *(u32x2*)(cb + r * 128 + 32 * kb + 8 * g + 4 * hi) = w; } }
        __syncthreads();
    }
}

constexpr int SC_W = 0, SC_QG = 17408, SC_KD = 34816, SC_QK = 53248, SC_UT = 62464, SC_BUF = 64768;
__device__ __forceinline__ void scan_piece(int q, int dv0, int& src, int& dst) {
    if (q < 2048) { const int r = q >> 10, w = q & 1023; src = q * 16; dst = r * 17408 + (w >> 4) * 272 + (w & 15) * 16; }
    else if (q < 3072) { const int w = q - 2048; src = q * 16; dst = SC_KD + (w >> 3) * 144 + (w & 7) * 16; }
    else if (q < 3584) { const int w = q - 3072; src = 65536 + w * 16; dst = SC_QK + (w >> 3) * 144 + (w & 7) * 16; }
    else { const int w = q - 3584; src = 49152 + (dv0 + (w >> 3)) * 128 + (w & 7) * 16; dst = SC_UT + (w >> 3) * 144 + (w & 7) * 16; }
}
constexpr int SC_XV = 131584, SC_XS = 133632;
__device__ __forceinline__ void scan_phase(const Params& p, LAS unsigned char* lds, int q, int wg, int tid) {
    if (wg >= 128) return;
    const int lane = tid & 63, fr = lane & 15, fq = lane >> 4, w = __builtin_amdgcn_readfirstlane(tid >> 6);
    const int xcd = wg & 7, jj = wg >> 3, bh = xcd * 2 + (jj >> 3), sl = jj & 7, dv0 = 16 * sl, b = bh >> 3, h = bh & 7;
    const bool helper = tid >= 256;
    const unsigned char* rec0 = p.ws + WS_PREP + (size_t)((q & 1) * 1024 + bh * 64) * CHUNK_ELEMS * 2;
#define SC_BAR() do { asm volatile("s_waitcnt lgkmcnt(0)" ::: "memory"); __builtin_amdgcn_s_barrier(); asm volatile("" ::: "memory"); } while (0)
    if (helper) {
        const int t = tid - 256, t7 = t & 127;
        const unsigned so = (unsigned)t * 16u, so14 = (unsigned)t7 * 16u;
        const int d0 = (t >> 4) * 272 + (t & 15) * 16, d1 = (t >> 3) * 144 + (t & 7) * 16, d14 = (t7 >> 3) * 144 + (t7 & 7) * 16;
        u32x4 R0[15], R1[15], R2[15];
#define SC_SRC(i) ((i) < 12 ? (i) * 4096 : (i) < 14 ? (i) * 4096 + 16384 : 49152 + dv0 * 128)
#define SC_DST(i) ((i) < 8 ? d0 + ((i) >> 2) * 17408 + ((i) & 3) * 4352 : (i) < 12 ? d1 + SC_KD + ((i) - 8) * 4608 : (i) < 14 ? d1 + SC_QK + ((i) - 12) * 4608 : d14 + SC_UT)
#define SC_LDH(R, c) do { const unsigned char* rp_ = rec0 + (size_t)(c) * (CHUNK_ELEMS * 2); _Pragma("unroll") for (int i = 0; i < 15; ++i) R[i] = *(const u32x4*)(rp_ + SC_SRC(i) + (i == 14 ? so14 : so)); } while (0)
#define SC_STH(R, bf) do { _Pragma("unroll") for (int i = 0; i < 15; ++i) *(LAS u32x4*)(lds + (bf) * SC_BUF + SC_DST(i)) = R[i]; } while (0)
        SC_LDH(R0, 0); SC_LDH(R1, 1); SC_LDH(R2, 2); SC_STH(R0, 0); SC_BAR();
#pragma unroll 1
        for (int n = 0; n < 60; n += 3) {
            SC_LDH(R0, n + 3); SC_STH(R1, (n + 1) & 1); SC_BAR(); SC_BAR();
            SC_LDH(R1, n + 4); SC_STH(R2, (n + 2) & 1); SC_BAR(); SC_BAR();
            SC_LDH(R2, n + 5); SC_STH(R0, (n + 3) & 1); SC_BAR(); SC_BAR();
        }
        SC_LDH(R0, 63); SC_STH(R1, 1); SC_BAR(); SC_BAR();
        SC_STH(R2, 0); SC_BAR(); SC_BAR();
        SC_STH(R0, 1); SC_BAR(); SC_BAR();
        SC_BAR(); SC_BAR();
#undef SC_LDH
#undef SC_STH
#undef SC_SRC
#undef SC_DST
    } else {
        f32x4* st = (f32x4*)(p.ws + WS_STATE) + (size_t)wg * 8 * 64 + lane;
        const float* GL = (const float*)(p.ws + WS_GL) + (q & 1) * 1024 + bh * 64;
        float* O = p.out;
        const float glr0 = GL[lane];
        f32x4 S0 = q ? st[(2 * w) * 64] : (f32x4){0.f, 0.f, 0.f, 0.f}, S1 = q ? st[(2 * w + 1) * 64] : (f32x4){0.f, 0.f, 0.f, 0.f};
        LAS unsigned char* XV = lds + SC_XV; LAS unsigned char* XS = lds + SC_XS;
        *(LAS bf16x8*)(XS + w * 1024 + lane * 16) = pack8(S0, S1);
        SC_BAR();
        const int aw = (16 * w + fr) * 272 + fq * 16, ak = (16 * w + fr) * 144 + fq * 16, akd = (32 * w + fr) * 144 + fq * 16;
#pragma unroll 1
        for (int n = 0; n < 64; ++n) {
            LAS unsigned char* B_ = lds + (n & 1) * SC_BUF;
            const float gl = __uint_as_float((unsigned)__builtin_amdgcn_readlane((int)__float_as_uint(glr0), n));
            bf16x8 Sb[4], Wf[4], QGf[4], QKf[2], KDf[2][2];
#pragma unroll
            for (int ks = 0; ks < 4; ++ks) { Sb[ks] = *(const LAS bf16x8*)(XS + ks * 1024 + lane * 16); Wf[ks] = *(const LAS bf16x8*)(B_ + SC_W + aw + ks * 64); }
            const u32x2 uw = *(const LAS u32x2*)(B_ + SC_UT + fr * 144 + w * 32 + fq * 8);
#pragma unroll
            for (int ks = 0; ks < 4; ++ks) QGf[ks] = *(const LAS bf16x8*)(B_ + SC_QG + aw + ks * 64);
            __builtin_amdgcn_sched_barrier(0);
#pragma unroll
            for (int k2 = 0; k2 < 2; ++k2) { QKf[k2] = *(const LAS bf16x8*)(B_ + SC_QK + ak + k2 * 64); KDf[0][k2] = *(const LAS bf16x8*)(B_ + SC_KD + akd + k2 * 64); KDf[1][k2] = *(const LAS bf16x8*)(B_ + SC_KD + akd + 2304 + k2 * 64); }
            f32x4 acc = {0.f, 0.f, 0.f, 0.f}, oa = {0.f, 0.f, 0.f, 0.f};
#pragma unroll
            for (int ks = 0; ks < 4; ++ks) { acc = MFMA16(Wf[ks], Sb[ks], acc); oa = MFMA16(QGf[ks], Sb[ks], oa); }
            const f32x4 vn = (f32x4){bflo(uw.x), bfhi(uw.x), bflo(uw.y), bfhi(uw.y)} - acc;
            { u32x2 pv = {cvtpk(vn[0], vn[1]), cvtpk(vn[2], vn[3])}; *(LAS u32x2*)(XV + (w >> 1) * 1024 + lane * 16 + (w & 1) * 8) = pv; }
            SC_BAR();
            bf16x8 Vb[2];
#pragma unroll
            for (int k2 = 0; k2 < 2; ++k2) Vb[k2] = *(const LAS bf16x8*)(XV + k2 * 1024 + lane * 16);
            S0 = S0 * gl; S1 = S1 * gl;
#pragma unroll
            for (int k2 = 0; k2 < 2; ++k2) { oa = MFMA16(QKf[k2], Vb[k2], oa); S0 = MFMA16(KDf[0][k2], Vb[k2], S0); S1 = MFMA16(KDf[1][k2], Vb[k2], S1); }
            *(LAS bf16x8*)(XS + w * 1024 + lane * 16) = pack8(S0, S1);
            { const size_t t0 = (size_t)b * SEQ + (size_t)(q * 64 + n) * 64; float* op = O + (t0 + 16 * w + 4 * fq) * DM + h * 128 + dv0 + fr;
#pragma unroll
              for (int e = 0; e < 4; ++e) op[e * DM] = oa[e]; }
            SC_BAR();
        }
        if (q < 3) { st[(2 * w) * 64] = S0; st[(2 * w + 1) * 64] = S1; }
    }
#undef SC_BAR
}

__device__ __forceinline__ void attn_phase(const Params& p, char* lds, int wg, int G) {
    using bf = att::bf16;
    const bf* Qb = (const bf*)(p.ws + WS_BIG); const bf* Kb = (const bf*)(p.ws + WS_BIG + 64 * MiB); const bf* Vb = (const bf*)(p.ws + WS_BIG + 128 * MiB);
    bf* Ob = (bf*)(p.ws + WS_O);
    constexpr int TOTAL = 1024;
    auto mkref = [&](int L, int pass) {
        int hidx, x;
        if ((G & 7) == 0) { const int xcd = L & 7, k = L >> 3; hidx = (k >> 5) * 8 + xcd; x = k & 31; } else { hidx = L >> 5; x = L & 31; }
        const int qb = pass ? x : 63 - x,     bh = hidx >> 2, m = (hidx >> 1) & 1, vh = hidx & 1, b = bh >> 2, h = bh & 3;
        att::BlockRef<bf, bf> r;
        r.Q = Qb + ((size_t)(bh * 2 + m) * SEQ + (size_t)qb * 256) * 128; r.K = Kb + (size_t)(bh * 2 + m) * SEQ * 128; r.V = Vb + (size_t)(bh * 2 + vh) * SEQ * 128;
        r.O = Ob + ((size_t)m * TT + (size_t)b * SEQ + (size_t)qb * 256) * DM + h * 256 + vh * 128; r.P0 = qb * 256;
        return r; };
    int L = wg; if (L >= TOTAL) return;
    int pass = 0;
    att::BlockRef<bf, bf> cur = mkref(L, 0);
    att::Seam<bf> S;
    int Wv = 1 << 30, skv = SEQ; asm volatile("" : "+s"(Wv), "+s"(skv));
    att::causal_swa_prime<bf, bf>(cur, Wv, lds, S);
    for (;;) {
        const bool more_pass = pass == 0, more_item = L + G < TOTAL, last = !more_pass && !more_item;
        int passn = pass + 1, Ln = L;
        if (!more_pass) { passn = 0; Ln = more_item ? L + G : L; }
        const att::BlockRef<bf, bf> nxt = last ? cur : mkref(Ln, passn);
        att::causal_swa_block<bf, bf>(cur, nxt, skv, Wv, lds, S);
        if (last) break;
        cur = nxt; pass = passn; L = Ln;
    }
}

#define XB_TMO      128
#define XB_XCNT(j)  (256  + 64 * (j))
#define XB_XSUB(j)  (1280 + 64 * (j))
#define XB_XGEN(j)  (2304 + 64 * (j))
#define XB_TOP      3328
#define XB_TOPGEN   3392
#define XCD_BAR_WORDS 3456
#define XB_SPIN_CAP (1u << 18)

__device__ __forceinline__ unsigned xb_ld(unsigned* p)              { return __hip_atomic_load(p, __ATOMIC_RELAXED, __HIP_MEMORY_SCOPE_AGENT); }
__device__ __forceinline__ unsigned xb_add(unsigned* p, unsigned v) { return __hip_atomic_fetch_add(p, v, __ATOMIC_RELAXED, __HIP_MEMORY_SCOPE_AGENT); }
__device__ __forceinline__ unsigned xb_xcc_id() { return (unsigned)__builtin_amdgcn_s_getreg((3 << 11) | 20) & 0xFu; }
#define XB_SPIN(cond, bar) do { unsigned _sp = 0; while (cond) { __builtin_amdgcn_s_sleep(1); \
    if ((++_sp & 255u) == 0u) { if (xb_ld(&(bar)[XB_TMO])) break; if (_sp > XB_SPIN_CAP) { atomicAdd(&(bar)[XB_TMO], 1u); break; } } } } while (0)

struct XcdBarrier {
    unsigned* bar; unsigned x;
    volatile LAS unsigned* st;
};

__device__ __forceinline__ XcdBarrier xcd_barrier_post(unsigned* bar, volatile LAS unsigned* st) {
    XcdBarrier b; b.bar = bar; b.x = xb_xcc_id(); b.st = st;
    if (threadIdx.x == 0) (void)xb_add(&bar[XB_XCNT(b.x)], 1u);
    return b;
}
__device__ __forceinline__ void xcd_barrier_complete(unsigned* bar, unsigned x, unsigned& nloc, unsigned& nx) {
    const unsigned G = gridDim.x * gridDim.y * gridDim.z;
    unsigned sum, cnt, mine, sp = 0u;
    for (;;) {
        sum = 0u; cnt = 0u; mine = 0u;
#pragma unroll
        for (unsigned j = 0; j < 16; ++j) { const unsigned c = xb_ld(&bar[XB_XCNT(j)]); sum += c; cnt += (c > 0u) ? 1u : 0u; mine = (j == x) ? c : mine; }
        if (sum == G) break;
        __builtin_amdgcn_s_sleep(1);
        if ((++sp & 255u) == 0u) { if (xb_ld(&bar[XB_TMO])) break; if (sp > XB_SPIN_CAP) { atomicAdd(&bar[XB_TMO], 1u); break; } }
    }
    nloc = mine > 0u ? mine : 1u; nx = cnt > 0u ? cnt : 1u;
}

__device__ __forceinline__ void xcd_barrier(const XcdBarrier& b) {
    asm volatile("s_waitcnt vmcnt(0)" ::: "memory");
    __syncthreads();
    if (threadIdx.x == 0) {
        unsigned* bar = b.bar;
        __builtin_amdgcn_s_waitcnt(0);
        unsigned nloc = b.st[0], nx = b.st[1];
        if (nloc == 0u) { xcd_barrier_complete(bar, b.x, nloc, nx); b.st[0] = nloc; b.st[1] = nx; }
        const unsigned old = xb_add(&bar[XB_XSUB(b.x)], 1u);
        const unsigned gen = old / nloc;
        if (old + 1u == (gen + 1u) * nloc) {
            __builtin_amdgcn_fence(__ATOMIC_RELEASE, "agent");
            asm volatile("s_waitcnt vmcnt(0)" ::: "memory");
            const unsigned og = xb_add(&bar[XB_TOP], 1u);
            const unsigned tg = og / nx;
            if (og + 1u == (tg + 1u) * nx) xb_add(&bar[XB_TOPGEN], 1u);
            else XB_SPIN(xb_ld(&bar[XB_TOPGEN]) == tg, bar);
            __builtin_amdgcn_fence(__ATOMIC_ACQUIRE, "agent");
            xb_add(&bar[XB_XGEN(b.x)], 1u);
            asm volatile("s_waitcnt vmcnt(0)" ::: "memory");
        } else {
            XB_SPIN(xb_ld(&bar[XB_XGEN(b.x)]) == gen, bar);
            __builtin_amdgcn_fence(__ATOMIC_ACQUIRE, "agent");
            asm volatile("s_waitcnt vmcnt(0)" ::: "memory");
        }
    }
    __syncthreads();
}
constexpr size_t WS_BARW = 7 * MiB;
constexpr int LDS_BARST = 131072 + 64;
__device__ __forceinline__ Params load_params(const Params& p) {
#if defined(__HIP_DEVICE_COMPILE__)
    const __attribute__((address_space(4))) Params* pq = (const __attribute__((address_space(4))) Params*)__builtin_amdgcn_kernarg_segment_ptr();
    asm volatile("" : "+s"(pq)); Params q = *pq; return q;
#else
    return p;
#endif
}
__global__ void __launch_bounds__(512, 2) mega(Params p) {
    extern __shared__ __attribute__((aligned(16))) unsigned char lds_raw[];
    LAS unsigned char* lds = (LAS unsigned char*)lds_raw;
    const int tid0 = threadIdx.x, wg0 = blockIdx.x, G0 = gridDim.x, ph_lo = p.ph_lo, ph_hi = p.ph_hi;
    if (tid0 < 8) ((LAS unsigned*)(lds + LDS_BARST))[tid0] = 0u;
    __syncthreads();
    XcdBarrier bar; bar.bar = nullptr; bar.x = 0; bar.st = nullptr;
    if (ph_hi - ph_lo > 1) bar = xcd_barrier_post((unsigned*)(load_params(p).ws + WS_BARW), (volatile LAS unsigned*)(lds + LDS_BARST));
    if (ph_lo < -1000) cg::this_grid().sync();
#ifndef PHMASK
#define PHMASK 0xFFFFFFFFu
#endif
#define PHSEL(k) (1)
#ifndef REPMASK
#define REPMASK 0u
#endif
#define REPSEL(k) (0)
#define PH_BEGIN(k) if (PHSEL(k) && ph_lo <= (k) && (k) < ph_hi) for (int rep_ = 0; rep_ < 1 + REPSEL(k); ++rep_) { int tid = tid0, wg = wg0, G = G0; asm volatile("" : "+v"(tid), "+s"(wg), "+s"(G)); Params q = load_params(p); unsigned char* ws = q.ws; \
        float* modv = (float*)(ws + WS_MOD); float* kvmod = (float*)(ws + WS_KVMOD); bf16_t* HB = (bf16_t*)(ws + WS_HB); bf16_t* HB2 = (bf16_t*)(ws + WS_HB2); bf16_t* HB3 = (bf16_t*)(ws + WS_HB3); \
        bf16_t* BIG = (bf16_t*)(ws + WS_BIG); bf16_t* H0 = (bf16_t*)q.out; (void)modv; (void)kvmod; (void)HB; (void)HB2; (void)HB3; (void)BIG; (void)H0; (void)tid;
#define PH_END(k) } do { if (ph_lo <= (k) && (k) + 1 < ph_hi) { xcd_barrier(bar); } } while (0)
    PH_BEGIN(0) p0_prologue(q, lds, wg, G, tid); PH_END(0);
    PH_BEGIN(1) modulate_phase<true>(q, lds, q.in[0], q.in[4], modv + 0 * 1024, modv + 1 * 1024, 6144, H0, wg, G, tid); PH_END(1);
    PH_BEGIN(2) pg8::Gemm g{H0, (const bf16_t*)(ws + WS_WIN), TT, 4096, 1024}; pg8::StaticOrder S; S.init(TT, 4096, G, wg); pg8::EpiStoreBf16 E{BIG, 4096, 0, 1};
            pg8::gemm_phase<pg8::EpiStoreBf16, pg8::StaticOrder, true, true>(lds, g, S, E); PH_END(2);
    PH_BEGIN(3) prep_phase(q, lds, 0, wg, G, (1024 - wg + G - 1) / G, tid); PH_END(3);
#define GDN_STAGE(ph, k) PH_BEGIN(ph) if (wg < 128) { scan_phase(q, lds, (k) - 1, wg, tid); __syncthreads(); } \
        if (G == 256) { if (wg < 128) prep_phase(q, lds, (k), 896 + wg, 1, 1, tid); else prep_phase(q, lds, (k), (wg - 128) * 7, 1, 7, tid); } \
        else prep_phase(q, lds, (k), wg, G, (1024 - wg + G - 1) / G, tid); PH_END(ph);
    GDN_STAGE(4, 1)
    GDN_STAGE(5, 2)
    GDN_STAGE(6, 3)
    PH_BEGIN(7) if (wg < 128) scan_phase(q, lds, 3, wg, tid); if (G <= 128) __syncthreads(); if (wg >= 128 || G <= 128) p0_weights(q, lds, 1, G <= 128 ? wg : wg - 128, G <= 128 ? G : G - 128, tid); PH_END(7);
    PH_BEGIN(8) gate_phase(q.out, BIG, q.in[10], HB, wg, G, tid); PH_END(8);
    PH_BEGIN(9) pg8::Gemm g{HB, (const bf16_t*)(ws + WS_WAO), TT, 1024, 1024}; pg8::StaticOrder S; S.init(TT, 1024, G, wg); pg8::EpiResid E{q.in[0], q.out, modv + 2 * 1024, 6144};
            pg8::gemm_phase<pg8::EpiResid, pg8::StaticOrder, true, true>(lds, g, S, E); PH_END(9);
#define MLP_PHASES(l, pb) \
    PH_BEGIN(pb) float* mv = modv + (l) * 2 * 6144; modulate_phase<false>(q, lds, q.out, q.in[5] + (l) * 1024, mv + 3 * 1024, mv + 4 * 1024, 6144, HB, wg, G, tid); PH_END(pb); \
    PH_BEGIN(pb + 1) pg8::Gemm g{HB, (const bf16_t*)(ws + WS_W1 + (size_t)(l) * 16 * MiB), TT, 4096, 1024}; pg8::StaticOrder S; S.init(TT, 4096, G, wg); pg8::EpiStoreBf16 E{BIG, 4096, 1, 0}; \
            pg8::gemm_phase<pg8::EpiStoreBf16, pg8::StaticOrder, true, true>(lds, g, S, E); PH_END(pb + 1); \
    PH_BEGIN(pb + 2) float* mv = modv + (l) * 2 * 6144; pg8::Gemm g{BIG, (const bf16_t*)(ws + WS_W2 + (size_t)(l) * 16 * MiB), TT, 1024, 4096}; pg8::StaticOrder S; S.init(TT, 1024, G, wg); pg8::EpiResid E{q.out, q.out, mv + 5 * 1024, 6144}; \
            pg8::gemm_phase<pg8::EpiResid, pg8::StaticOrder, true, true>(lds, g, S, E); PH_END(pb + 2);
    MLP_PHASES(0, 10)
    PH_BEGIN(13) modulate2_phase(q.out, q.in[14], kvmod, kvmod + 1024, 2048, HB2, q.in[4] + 1024, modv + 2 * 6144, modv + 2 * 6144 + 1024, 6144, HB, wg, G, tid); PH_END(13);
    PH_BEGIN(14) const float* rc = (const float*)(ws + WS_ROPEC); const float* rs = (const float*)(ws + WS_ROPES);
        { pg8::Gemm g{HB2, (const bf16_t*)(ws + WS_WKV), TT, 2048, 1024}; pg8::StaticOrder S; S.init(TT, 2048, G, wg); pg8::EpiRope E{BIG + 32 * MiB, BIG + 64 * MiB, rc, rs, 4};
          pg8::gemm_phase<pg8::EpiRope, pg8::StaticOrder, true, true>(lds, g, S, E); }
        __syncthreads();
        { unsigned char* ws2 = ws; int wg2 = wg, G2 = G; asm volatile("" : "+s"(ws2), "+s"(wg2), "+s"(G2)); const float* rc2 = (const float*)(ws2 + WS_ROPEC); const float* rs2 = (const float*)(ws2 + WS_ROPES); bf16_t* Q2 = (bf16_t*)(ws2 + WS_BIG);
          pg8::Gemm g{(const bf16_t*)(ws2 + WS_HB), (const bf16_t*)(ws2 + WS_WQ), TT, 1024, 1024}; pg8::StaticOrder S; S.init(TT, 1024, G2, wg2); pg8::EpiRope E{Q2, Q2, rc2, rs2, 4};
          pg8::gemm_phase<pg8::EpiRope, pg8::StaticOrder, true, true>(lds, g, S, E); } PH_END(14);
    PH_BEGIN(15) attn_phase(q, (char*)lds_raw, wg, G); PH_END(15);
    PH_BEGIN(16) combine_phase(q, (const bf16_t*)(ws + WS_O), HB3, wg, G, tid); PH_END(16);
    PH_BEGIN(17) pg8::Gemm g{HB3, (const bf16_t*)(ws + WS_WBO), TT, 1024, 1024}; pg8::StaticOrder S; S.init(TT, 1024, G, wg); pg8::EpiResid E{q.out, q.out, modv + 2 * 6144 + 2 * 1024, 6144};
        pg8::gemm_phase<pg8::EpiResid, pg8::StaticOrder, true, true>(lds, g, S, E); PH_END(17);
    MLP_PHASES(1, 18)
    PH_BEGIN(21) final_phase(q.out, q.in[22], wg, G, tid); }
#undef PH_BEGIN
#undef PH_END
}

extern "C" void kernel_launch(void* const* d_in, const int* in_sizes, int n_in, void* d_out, int out_size, void* d_ws, size_t ws_size, hipStream_t stream) {
    static int grid = 0;
    if (grid == 0) {
        if (n_in != 23 || out_size != TT * DM || ws_size < WS_END) { fprintf(stderr, "kernel_launch: unexpected shapes n_in %d out %d ws %zu\n", n_in, out_size, ws_size); grid = -1; return; }
        int dev = 0, cus = 0, per_cu = 0;
        (void)hipGetDevice(&dev); (void)hipDeviceGetAttribute(&cus, hipDeviceAttributeMultiprocessorCount, dev);
        if (hipFuncSetAttribute((const void*)mega, hipFuncAttributeMaxDynamicSharedMemorySize, LDS_BYTES) != hipSuccess) { fprintf(stderr, "kernel_launch: hipFuncSetAttribute failed\n"); grid = -1; return; }
        if (hipOccupancyMaxActiveBlocksPerMultiprocessor(&per_cu, (const void*)mega, 512, LDS_BYTES) != hipSuccess || per_cu < 1) { fprintf(stderr, "kernel_launch: occupancy query says %d\n", per_cu); per_cu = 1; }
        (void)hipGetLastError();
        grid = cus * 1;
        if (grid <= 0) grid = 256;
    }
    if (grid < 0) return;
    Params p{};
    for (int i = 0; i < 23; ++i) p.in[i] = (const float*)d_in[i];
    p.out = (float*)d_out; p.ws = (unsigned char*)d_ws;
#if MK_SINGLE
    if (hipMemsetAsync((unsigned char*)d_ws + WS_BARW, 0, XCD_BAR_WORDS * 4, stream) != hipSuccess) { fprintf(stderr, "kernel_launch: memset of the barrier words failed\n"); return; }
    p.ph_lo = 0; p.ph_hi = NPH;
    void* args[] = {&p};
    hipError_t e = hipLaunchCooperativeKernel((const void*)mega, dim3(grid), dim3(512), args, LDS_BYTES, stream);
    if (e != hipSuccess) fprintf(stderr, "cooperative launch failed: %s (grid %d)\n", hipGetErrorString(e), grid);
#else
    for (int ph = 0; ph < NPH; ++ph) { p.ph_lo = ph; p.ph_hi = ph + 1; hipLaunchKernelGGL(mega, dim3(grid), dim3(512), LDS_BYTES, stream, p); }
#endif
}
```

```cpp
#include <hip/hip_runtime.h>
#include <hip/hip_bf16.h>
#include <hip/hip_cooperative_groups.h>
#include <cstdio>
#include <cstdint>
namespace cg = cooperative_groups;
#ifndef MK_SINGLE
#define MK_SINGLE 1
#endif
typedef _Float16 h16x8 __attribute__((ext_vector_type(8)));
typedef _Float16 h16x2 __attribute__((ext_vector_type(2)));
typedef float mf32x4 __attribute__((ext_vector_type(4)));
typedef float mf32x16 __attribute__((ext_vector_type(16)));
template <class A, class B> __device__ __forceinline__ mf32x4 MFMA16(A a, B b, mf32x4 c, int = 0, int = 0, int = 0) { return __builtin_amdgcn_mfma_f32_16x16x32_f16(__builtin_bit_cast(h16x8, a), __builtin_bit_cast(h16x8, b), c, 0, 0, 0); }
typedef __bf16 bf16x2_t __attribute__((ext_vector_type(2)));
typedef short sh16x8 __attribute__((ext_vector_type(8)));
template <class A, class B> __device__ __forceinline__ mf32x4 MFMA16B(A a, B b, mf32x4 c, int = 0, int = 0, int = 0) { return __builtin_amdgcn_mfma_f32_16x16x32_bf16(__builtin_bit_cast(sh16x8, a), __builtin_bit_cast(sh16x8, b), c, 0, 0, 0); }
template <class A, class B> __device__ __forceinline__ mf32x16 MFMA32B(A a, B b, mf32x16 c, int = 0, int = 0, int = 0) { return __builtin_amdgcn_mfma_f32_32x32x16_bf16(__builtin_bit_cast(sh16x8, a), __builtin_bit_cast(sh16x8, b), c, 0, 0, 0); }
__device__ __forceinline__ unsigned pkbf(float lo, float hi) { bf16x2_t v = {(__bf16)lo, (__bf16)hi}; return __builtin_bit_cast(unsigned, v); }
__device__ __forceinline__ unsigned pkf16(float lo, float hi) { h16x2 v = {(_Float16)lo, (_Float16)hi}; return __builtin_bit_cast(unsigned, v); }
__device__ __forceinline__ float f16lo(unsigned w) { return (float)__builtin_bit_cast(h16x2, w)[0]; }
__device__ __forceinline__ float f16hi(unsigned w) { return (float)__builtin_bit_cast(h16x2, w)[1]; }
template <class A, class B> __device__ __forceinline__ mf32x16 MFMA32(A a, B b, mf32x16 c, int = 0, int = 0, int = 0) { return __builtin_amdgcn_mfma_f32_32x32x16_f16(__builtin_bit_cast(h16x8, a), __builtin_bit_cast(h16x8, b), c, 0, 0, 0); }
namespace pg8 {
#define PG8_LAS __attribute__((address_space(3)))
typedef unsigned short bf16_t;
typedef short bf16x8 __attribute__((ext_vector_type(8)));
typedef float f32x4 __attribute__((ext_vector_type(4)));
typedef unsigned u32x4 __attribute__((ext_vector_type(4)));
constexpr int BM = 256, BK = 64, HALF = 128, HTB = HALF * BK * 2  , STAGE_BYTES = 8 * HTB, NXCD = 8, WGM = 8;

__host__ __device__ __forceinline__ int lds_byte(int r, int c) { const int st = (r >> 4) * 2 + (c >> 5), rr = r & 15, cc = c & 31, ob = rr * 64 + cc * 2; return st * 1024 + (ob ^ (((ob >> 9) & 1) << 5)); }
__host__ __device__ __forceinline__ void stage_rc(int b, int& R, int& C) { const int st = b / 1024, sb = b % 1024, swz = sb ^ (((sb >> 9) & 1) << 5); R = (st >> 1) * 16 + swz / 64; C = (st & 1) * 32 + (swz % 64) / 2; }
__host__ __device__ __forceinline__ int perm32(int rho) { const int n = rho >> 4, i = rho & 15; return 8 * (i >> 2) + 4 * n + (i & 3); }

struct Unit { int pm, pn; };
struct Gemm { const bf16_t* A; const bf16_t* Bt; int M, N, K; };

struct StaticOrder {
    int nM, nN, nwg, G, c;
    __host__ __device__ void init(int M, int N, int G_, int c_) { nM = M / BM; nN = N / BM; nwg = nM * nN; G = G_; c = c_; }
    __host__ __device__ bool next(int i, Unit& u) const {
        const long L = (long)i * G + c; if (L >= nwg) return false;
        int wgid = (int)L; { const int q = nwg / NXCD, r = nwg % NXCD, xcd = wgid % NXCD, off = wgid / NXCD; wgid = (xcd < r ? xcd * (q + 1) : r * (q + 1) + (xcd - r) * q) + off; }
        const int nig = WGM * nN, gid = wgid / nig, fm = gid * WGM, gsz = (nM - fm) < WGM ? (nM - fm) : WGM;
        u.pm = fm + ((wgid % nig) % gsz); u.pn = (wgid % nig) / gsz; return true;
    }
    __device__ __forceinline__ void a_ready(const Unit&) const {}
    __device__ __forceinline__ void done(const Unit&) const {}
};

__device__ __forceinline__ unsigned cvt_pk_bf16(float lo, float hi) { return pkbf(lo, hi); }
typedef float f32x2 __attribute__((ext_vector_type(2)));
__device__ __forceinline__ f32x2 gelu_pk(f32x2 v) {
    const f32x2 av = __builtin_elementwise_abs(v), d = av * 0.2316418882f + 1.0f;
    f32x2 t; t.x = __builtin_amdgcn_rcpf(d.x); t.y = __builtin_amdgcn_rcpf(d.y);
    f32x2 q = t * 0.5307027145f + (-0.7265760135f); q = q * t + 0.7107068705f; q = q * t + (-0.142248368f); q = q * t + 0.127414796f; q = q * t;
    const f32x2 s = (v * v) * (-0.72134752044f);
    f32x2 e; e.x = __builtin_amdgcn_exp2f(s.x); e.y = __builtin_amdgcn_exp2f(s.y);
    const f32x2 m = v * (q * e), r = v - m;
    f32x2 o; o.x = v.x < 0.f ? m.x : r.x; o.y = v.y < 0.f ? m.y : r.y; return o;
}

template <int ACT  > struct EpiBf16 {
    static constexpr bool PERM = true, AFTER_DRAIN = false; static_assert(ACT == 0 || ACT == 1, "EpiBf16: ACT is 0 (none) or 1 (gelu_pk)");
    bf16_t* O; int ldc; const float* bias; int split_cols; size_t split_stride; float scale0;
    __device__ __forceinline__ void operator()(const f32x4 (&acc)[2][2][4][2], const Unit& u, int wr, int wc, int fr, int fq) const {
        const int row0 = u.pm * BM + wr * 64 + fr; int colt = u.pn * BM; bf16_t* base = O;
        float sc = 1.f; if (split_cols) { const int t = colt / split_cols; base += (size_t)t * split_stride; colt -= t * split_cols; if (t == 0) sc = scale0; }
        const int col0 = colt + wc * 32 + 8 * fq, bcol0 = u.pn * BM + wc * 32 + 8 * fq;
        f32x4 bv[2][2];
#pragma unroll
        for (int bj = 0; bj < 2; ++bj)
#pragma unroll
            for (int n = 0; n < 2; ++n) bv[bj][n] = bias ? *(const f32x4*)(bias + bcol0 + bj * HALF + 4 * n) : (f32x4){0.f, 0.f, 0.f, 0.f};
#pragma unroll
        for (int ai = 0; ai < 2; ++ai)
#pragma unroll
            for (int m = 0; m < 4; ++m) { bf16_t* rowp = base + (size_t)(row0 + ai * HALF + m * 16) * ldc + col0;
#pragma unroll
                for (int bj = 0; bj < 2; ++bj) { f32x4 v0 = acc[ai][bj][m][0] + bv[bj][0], v1 = acc[ai][bj][m][1] + bv[bj][1];
                    if (ACT == 1) { f32x2 a = gelu_pk((f32x2){v0[0], v0[1]}), b = gelu_pk((f32x2){v0[2], v0[3]}), c = gelu_pk((f32x2){v1[0], v1[1]}), d = gelu_pk((f32x2){v1[2], v1[3]});
                        v0 = (f32x4){a.x, a.y, b.x, b.y}; v1 = (f32x4){c.x, c.y, d.x, d.y}; }
                    v0 = v0 * sc; v1 = v1 * sc; u32x4 w; w.x = cvt_pk_bf16(v0[0], v0[1]); w.y = cvt_pk_bf16(v0[2], v0[3]); w.z = cvt_pk_bf16(v1[0], v1[1]); w.w = cvt_pk_bf16(v1[2], v1[3]);
                    *(u32x4*)(rowp + bj * HALF) = w; } }
    }
};

template <class Epi, class Sched, bool ALIGN_EPI = false, bool SP2 = false>
__device__ __forceinline__ void gemm_phase(PG8_LAS unsigned char* lds, const Gemm g, const Sched& S, const Epi& E) {
    int tid = threadIdx.x; asm volatile("" : "+v"(tid));
    const int wid = __builtin_amdgcn_readfirstlane(tid >> 6), lane = tid & 63, wr = wid >> 2, wc = wid & 3, fr = lane & 15, fq = lane >> 4;
    const int K = g.K, nt = K / BK;
    unsigned voffA[2], voffB[2];
#pragma unroll
    for (int i = 0; i < 2; ++i) { int R, C; stage_rc(tid * 16 + i * 8192, R, C); const int Rb = Epi::PERM ? ((R & ~31) + perm32(R & 31)) : R;
        voffA[i] = (unsigned)(R * K + C) * 2u; voffB[i] = (unsigned)(Rb * K + C) * 2u; }
    const size_t kstep = (size_t)(BK * 2);
    const size_t hstep = (size_t)HALF * K * 2;
    const size_t tstep = 2 * hstep;
    const unsigned ldsw = (unsigned)wid * 1024u;
    const int aoff = lds_byte(wr * 64 + fr, fq * 8), boff = lds_byte(wc * 32 + fr, fq * 8);
#define PG8_SA(b, h) (((b) * 2 + (h)) * HTB)
#define PG8_SB(b, h) ((4 + (b) * 2 + (h)) * HTB)
#define PG8_STAGE(bufoff, gbase, voff) do { _Pragma("unroll") for (int _i = 0; _i < 2; ++_i) \
        __builtin_amdgcn_global_load_lds((const unsigned*)((const char*)(gbase) + (voff)[_i]), (PG8_LAS unsigned*)(lds + (bufoff) + ldsw + _i * 8192), 16, 0, 0); } while (0)
#define PG8_LDA(dst, b, h) do { _Pragma("unroll") for (int m = 0; m < 4; ++m) _Pragma("unroll") for (int k = 0; k < 2; ++k) dst[m][k] = *(const PG8_LAS bf16x8*)(lds + PG8_SA(b, h) + aoff + m * 2048 + k * 1024); } while (0)
#define PG8_LDB(dst, b, h) do { _Pragma("unroll") for (int n = 0; n < 2; ++n) _Pragma("unroll") for (int k = 0; k < 2; ++k) dst[n][k] = *(const PG8_LAS bf16x8*)(lds + PG8_SB(b, h) + boff + n * 2048 + k * 1024); } while (0)
#define PG8_MMA(ai, bj, At, Bt) do { __builtin_amdgcn_s_setprio(1); _Pragma("unroll") for (int m = 0; m < 4; ++m) _Pragma("unroll") for (int n = 0; n < 2; ++n) _Pragma("unroll") for (int k = 0; k < 2; ++k) \
        acc[ai][bj][m][n] = MFMA16B(Bt[n][k], At[m][k], acc[ai][bj][m][n], 0, 0, 0); __builtin_amdgcn_s_setprio(0); } while (0)
#define PG8_WAIT_V(n) asm volatile("s_waitcnt vmcnt(" #n ")" ::: "memory")
#define PG8_WAIT_L(n) asm volatile("s_waitcnt lgkmcnt(" #n ")" ::: "memory")
#define PG8_BAR __builtin_amdgcn_s_barrier()
#define PG8_SCHED __builtin_amdgcn_sched_barrier(0)
    Unit cur, nxt; int ui = 0;
    if (!S.next(0, cur)) return;
    f32x4 acc[2][2][4][2];
#pragma unroll
    for (int a = 0; a < 2; ++a)
#pragma unroll
        for (int b = 0; b < 2; ++b)
#pragma unroll
            for (int m = 0; m < 4; ++m)
#pragma unroll
                for (int n = 0; n < 2; ++n) acc[a][b][m][n] = (f32x4){0.f, 0.f, 0.f, 0.f};
    bf16x8 At[4][2], B0[2][2], B1[2][2];
    const char* cA = (const char*)g.A + (size_t)cur.pm * tstep; const char* cB = (const char*)g.Bt + (size_t)cur.pn * tstep;
    S.a_ready(cur);
    if constexpr (SP2) {
        PG8_STAGE(PG8_SB(0, 0), cB, voffB); PG8_STAGE(PG8_SB(0, 1), cB + hstep, voffB); PG8_STAGE(PG8_SA(0, 0), cA, voffA); PG8_STAGE(PG8_SA(0, 1), cA + hstep, voffA);
        if (wr == 1) PG8_BAR;
        PG8_WAIT_V(2); PG8_BAR;
        PG8_STAGE(PG8_SB(1, 0), cB + kstep, voffB); PG8_STAGE(PG8_SA(1, 0), cA + kstep, voffA); PG8_STAGE(PG8_SB(1, 1), cB + hstep + kstep, voffB);
        PG8_WAIT_V(6); PG8_BAR;
    } else {
        PG8_STAGE(PG8_SB(0, 0), cB, voffB); PG8_STAGE(PG8_SA(0, 0), cA, voffA); PG8_STAGE(PG8_SB(0, 1), cB + hstep, voffB); PG8_STAGE(PG8_SA(0, 1), cA + hstep, voffA);
        if (wr == 1) PG8_BAR;
        PG8_WAIT_V(4); PG8_BAR;
        PG8_STAGE(PG8_SB(1, 0), cB + kstep, voffB); PG8_STAGE(PG8_SA(1, 0), cA + kstep, voffA); PG8_STAGE(PG8_SB(1, 1), cB + hstep + kstep, voffB);
        PG8_WAIT_V(6); PG8_BAR;
    }
    for (;;) {
        const bool has_next = S.next(ui + 1, nxt);
        const char* nA = has_next ? (const char*)g.A + (size_t)nxt.pm * tstep : cA; const char* nB = has_next ? (const char*)g.Bt + (size_t)nxt.pn * tstep : cB;
        for (int t = 0; t < nt; t += 2) {
            const bool last = (t == nt - 2);
            const char* a1 = cA + (size_t)(t + 1) * kstep;
            const char* a2 = last ? nA : cA + (size_t)(t + 2) * kstep; const char* b2 = last ? nB : cB + (size_t)(t + 2) * kstep;
            const char* a3 = a2 + kstep; const char* b3 = b2 + kstep;
            if (last && has_next) S.a_ready(nxt);
            if constexpr (SP2) {
            PG8_LDB(B0, 0, 0); PG8_LDB(B1, 0, 1); PG8_SCHED; PG8_LDA(At, 0, 0); PG8_STAGE(PG8_SA(1, 1), a1 + hstep, voffA);
            PG8_WAIT_V(8); PG8_WAIT_L(0); PG8_BAR; PG8_MMA(0, 0, At, B0); PG8_MMA(0, 1, At, B1); PG8_BAR; PG8_SCHED;
            PG8_LDA(At, 0, 1); PG8_STAGE(PG8_SB(0, 0), b2, voffB); PG8_STAGE(PG8_SB(0, 1), b2 + hstep, voffB); PG8_STAGE(PG8_SA(0, 0), a2, voffA);
            PG8_WAIT_V(8); PG8_WAIT_L(0); PG8_BAR; PG8_MMA(1, 0, At, B0); PG8_MMA(1, 1, At, B1); PG8_BAR; PG8_SCHED;
            PG8_LDB(B0, 1, 0); PG8_LDB(B1, 1, 1); PG8_SCHED; PG8_LDA(At, 1, 0); PG8_STAGE(PG8_SA(0, 1), a2 + hstep, voffA);
            PG8_WAIT_V(8); PG8_WAIT_L(0); PG8_BAR; PG8_MMA(0, 0, At, B0); PG8_MMA(0, 1, At, B1); PG8_BAR; PG8_SCHED;
            PG8_LDA(At, 1, 1); PG8_STAGE(PG8_SB(1, 0), b3, voffB); PG8_STAGE(PG8_SB(1, 1), b3 + hstep, voffB); PG8_STAGE(PG8_SA(1, 0), a3, voffA);
            PG8_WAIT_V(8); PG8_WAIT_L(0); PG8_BAR; PG8_MMA(1, 0, At, B0); PG8_MMA(1, 1, At, B1); PG8_BAR; PG8_SCHED;
            } else {
            PG8_LDB(B0, 0, 0); PG8_SCHED; PG8_LDA(At, 0, 0); PG8_STAGE(PG8_SA(1, 1), a1 + hstep, voffA);
            PG8_WAIT_L(8); PG8_BAR; PG8_WAIT_L(0); PG8_MMA(0, 0, At, B0); PG8_BAR; PG8_SCHED;
            PG8_LDB(B1, 0, 1); PG8_STAGE(PG8_SB(0, 0), b2, voffB);
            PG8_BAR; PG8_WAIT_L(0); PG8_MMA(0, 1, At, B1); PG8_BAR;
            PG8_LDA(At, 0, 1); PG8_STAGE(PG8_SA(0, 0), a2, voffA);
            PG8_BAR; PG8_WAIT_L(0); PG8_MMA(1, 0, At, B0); PG8_BAR; PG8_SCHED;
            PG8_STAGE(PG8_SB(0, 1), b2 + hstep, voffB);
            PG8_WAIT_V(6); PG8_BAR; PG8_MMA(1, 1, At, B1); PG8_BAR;
            PG8_LDB(B0, 1, 0); PG8_SCHED; PG8_LDA(At, 1, 0); PG8_STAGE(PG8_SA(0, 1), a2 + hstep, voffA);
            PG8_WAIT_L(8); PG8_BAR; PG8_WAIT_L(0); PG8_MMA(0, 0, At, B0); PG8_BAR; PG8_SCHED;
            PG8_LDB(B1, 1, 1); PG8_STAGE(PG8_SB(1, 0), b3, voffB);
            PG8_BAR; PG8_WAIT_L(0); PG8_MMA(0, 1, At, B1); PG8_BAR;
            PG8_LDA(At, 1, 1); PG8_STAGE(PG8_SA(1, 0), a3, voffA);
            PG8_BAR; PG8_WAIT_L(0); PG8_MMA(1, 0, At, B0); PG8_BAR; PG8_SCHED;
            PG8_STAGE(PG8_SB(1, 1), b3 + hstep, voffB);
            PG8_WAIT_V(6); PG8_BAR; PG8_MMA(1, 1, At, B1); PG8_BAR;
            }
        }
        if constexpr (ALIGN_EPI) { if (wr == 0) PG8_BAR; }
        if constexpr (!Epi::AFTER_DRAIN) { E(acc, cur, wr, wc, fr, fq); S.done(cur); }
        if (!has_next) break;
#pragma unroll
        for (int a = 0; a < 2; ++a)
#pragma unroll
            for (int b = 0; b < 2; ++b)
#pragma unroll
                for (int m = 0; m < 4; ++m)
#pragma unroll
                    for (int n = 0; n < 2; ++n) acc[a][b][m][n] = (f32x4){0.f, 0.f, 0.f, 0.f};
        cur = nxt; cA = nA; cB = nB; ++ui;
        if constexpr (ALIGN_EPI) { if (wr == 1) PG8_BAR; }
    }
    PG8_WAIT_V(0);
    if constexpr (!ALIGN_EPI) { if (wr == 0) PG8_BAR; }
    PG8_BAR;
    if constexpr (Epi::AFTER_DRAIN) { E.fused(acc, cur, wr, wc, fr, fq, lds, wid, lane); S.done(cur); }
#undef PG8_SA
#undef PG8_SB
#undef PG8_STAGE
#undef PG8_LDA
#undef PG8_LDB
#undef PG8_MMA
#undef PG8_WAIT_V
#undef PG8_WAIT_L
#undef PG8_BAR
#undef PG8_SCHED
}
}
namespace pg8 {
typedef unsigned u32x2 __attribute__((ext_vector_type(2)));
struct EpiStoreBf16 {
    static constexpr bool PERM = true, AFTER_DRAIN = false;
    bf16_t* O; int ldc; int act; int f16out;
    __device__ __forceinline__ void operator()(const f32x4 (&acc)[2][2][4][2], const Unit& u, int wr, int wc, int fr, int fq) const {
        const int row0 = u.pm * BM + wr * 64 + fr; const int col0 = u.pn * BM + wc * 32 + 8 * fq;
#pragma unroll
        for (int ai = 0; ai < 2; ++ai)
#pragma unroll
            for (int m = 0; m < 4; ++m) { bf16_t* rowp = O + (size_t)(row0 + ai * HALF + m * 16) * ldc + col0;
#pragma unroll
                for (int bj = 0; bj < 2; ++bj) { f32x4 v0 = acc[ai][bj][m][0], v1 = acc[ai][bj][m][1];
                    if (act == 1) {
#pragma unroll
                        for (int e = 0; e < 4; ++e) { float a = fmaxf(v0[e], 0.f), b = fmaxf(v1[e], 0.f); v0[e] = a * a; v1[e] = b * b; } }
                    u32x4 w; if (f16out) { w.x = pkf16(v0[0], v0[1]); w.y = pkf16(v0[2], v0[3]); w.z = pkf16(v1[0], v1[1]); w.w = pkf16(v1[2], v1[3]); }
                    else { w.x = cvt_pk_bf16(v0[0], v0[1]); w.y = cvt_pk_bf16(v0[2], v0[3]); w.z = cvt_pk_bf16(v1[0], v1[1]); w.w = cvt_pk_bf16(v1[2], v1[3]); }
                    *(u32x4*)(rowp + bj * HALF) = w; } }
    }
};
struct EpiResid {
    static constexpr bool PERM = false, AFTER_DRAIN = false;
    const float* base; float* out; const float* gate; int gstride;
    __device__ __forceinline__ void operator()(const f32x4 (&acc)[2][2][4][2], const Unit& u, int wr, int wc, int fr, int fq) const {
        const int row0 = u.pm * BM + wr * 64 + fr; const int col0 = u.pn * BM + wc * 32 + 4 * fq;
        const float* gp = gate + (size_t)(u.pm >= 64 ? gstride : 0) + col0;
#pragma unroll
        for (int bj = 0; bj < 2; ++bj)
#pragma unroll
            for (int n = 0; n < 2; ++n) { const f32x4 gv = *(const f32x4*)(gp + bj * HALF + n * 16);
#pragma unroll
                for (int ai = 0; ai < 2; ++ai)
#pragma unroll
                    for (int m = 0; m < 4; ++m) { const size_t off = (size_t)(row0 + ai * HALF + m * 16) * 1024 + col0 + bj * HALF + n * 16;
                        const f32x4 bs = *(const f32x4*)(base + off); *(f32x4*)(out + off) = bs + gv * acc[ai][bj][m][n]; } }
    }
};
template <bool BASE_F32> struct EpiResidS {
    static constexpr bool PERM = false, AFTER_DRAIN = false;
    const void* base; bf16_t* out; const float* gate; int gstride;
    __device__ __forceinline__ void operator()(const f32x4 (&acc)[2][2][4][2], const Unit& u, int wr, int wc, int fr_, int fq_) const {
        int fr = fr_, fq = fq_; asm volatile("" : "+v"(fr), "+v"(fq));
        const int row0 = u.pm * BM + wr * 64 + fr; const int col0 = u.pn * BM + wc * 32 + 4 * fq;
        const float* gp = gate + (size_t)(u.pm >= 64 ? gstride : 0) + col0;
        f32x4 gv[2][2];
#pragma unroll
        for (int bj = 0; bj < 2; ++bj)
#pragma unroll
            for (int n = 0; n < 2; ++n) gv[bj][n] = *(const f32x4*)(gp + bj * HALF + n * 16);
#pragma unroll
        for (int ai = 0; ai < 2; ++ai) { f32x4 bs[4][2][2];
#pragma unroll
            for (int m = 0; m < 4; ++m)
#pragma unroll
                for (int bj = 0; bj < 2; ++bj)
#pragma unroll
                    for (int n = 0; n < 2; ++n) { const size_t off = (size_t)(row0 + ai * HALF + m * 16) * 1024 + col0 + bj * HALF + n * 16;
                        if (BASE_F32) bs[m][bj][n] = *(const f32x4*)((const float*)base + off);
                        else { const u32x2 t = *(const u32x2*)((const bf16_t*)base + off); bs[m][bj][n] = (f32x4){f16lo(t.x), f16hi(t.x), f16lo(t.y), f16hi(t.y)}; } }
            asm volatile("" ::: "memory");
#pragma unroll
            for (int m = 0; m < 4; ++m)
#pragma unroll
                for (int bj = 0; bj < 2; ++bj)
#pragma unroll
                    for (int n = 0; n < 2; ++n) { const size_t off = (size_t)(row0 + ai * HALF + m * 16) * 1024 + col0 + bj * HALF + n * 16;
                        const f32x4 o = bs[m][bj][n] + gv[bj][n] * acc[ai][bj][m][n]; u32x2 w; w.x = pkf16(o[0], o[1]); w.y = pkf16(o[2], o[3]); *(u32x2*)(out + off) = w; }
            asm volatile("" ::: "memory"); }
    }
};
struct EpiRope {
    static constexpr bool PERM = false, AFTER_DRAIN = false;
    bf16_t* dstK; bf16_t* dstV; const float* cs; const float* sn; int nrope;
    __device__ __forceinline__ void operator()(const f32x4 (&acc)[2][2][4][2], const Unit& u, int wr, int wc, int fr_, int fq_) const {
        int fr = fr_, fq = fq_; asm volatile("" : "+v"(fr), "+v"(fq));
        const int b = u.pm >> 6, s0 = (u.pm & 63) * 256; const bool rope = u.pn < nrope; const int head = rope ? u.pn : u.pn - nrope;
        bf16_t* dst = rope ? dstK : dstV;
#pragma unroll
        for (int ai = 0; ai < 2; ++ai)
#pragma unroll
            for (int m = 0; m < 4; ++m) { const int srow = s0 + ai * HALF + wr * 64 + m * 16 + fr;
                f32x4 c4 = {1.f, 1.f, 1.f, 1.f}, s4 = {0.f, 0.f, 0.f, 0.f};
                if (rope && wc == 0) { c4 = *(const f32x4*)(cs + (size_t)srow * 16 + 4 * fq); s4 = *(const f32x4*)(sn + (size_t)srow * 16 + 4 * fq); }
#pragma unroll
                for (int bj = 0; bj < 2; ++bj) { bf16_t* bp = dst + ((size_t)((b * 4 + head) * 2 + bj) * 16384 + srow) * 128 + wc * 32 + 4 * fq;
                    f32x4 v0 = acc[ai][bj][m][0], v1 = acc[ai][bj][m][1];
                    if (rope && wc == 0) { const f32x4 o0 = v0 * c4 - v1 * s4, o1 = v1 * c4 + v0 * s4; v0 = o0; v1 = o1; }
                    u32x2 w0, w1; w0.x = cvt_pk_bf16(v0[0], v0[1]); w0.y = cvt_pk_bf16(v0[2], v0[3]); w1.x = cvt_pk_bf16(v1[0], v1[1]); w1.y = cvt_pk_bf16(v1[2], v1[3]);
                    *(u32x2*)bp = w0; *(u32x2*)(bp + 16) = w1; }
                asm volatile("" ::: "memory"); }
    }
};
}
namespace att {
constexpr int D = 128, OLD = 1024;
constexpr float THR = 8.f; constexpr bool WSKIP = false;
using bf16 = __hip_bfloat16;
typedef short bf16x8 __attribute__((ext_vector_type(8)));
typedef short s16x4 __attribute__((ext_vector_type(4)));
typedef float f32x16 __attribute__((ext_vector_type(16)));
typedef float f32x4 __attribute__((ext_vector_type(4)));
typedef unsigned u32x4 __attribute__((ext_vector_type(4)));
template <class A, class Bt> struct same_t { static constexpr bool v = false; };
template <class A> struct same_t<A, A> { static constexpr bool v = true; };
constexpr float SCALE = 0.08838834764831845f;
constexpr int NW = 8, QBLK = 32, KVBLK = 64, QB = NW * QBLK;
constexpr int SHM_V = KVBLK * D * 2, SHM_K = KVBLK * D * 2;
constexpr int ATT_LDS_BYTES = 2 * SHM_V + 2 * SHM_K + NW * 64 * 4;


#define KSWZ(row, colB) ((row) * 256 + ((colB) ^ (((row) & 7) << 4)))
#define SBAR() __builtin_amdgcn_sched_barrier(0)
__device__ __forceinline__ int v_st(int k, int c) { const int kk = (k & ~0xC) | ((k & 4) << 1) | ((k & 8) >> 1); return ((kk >> 3) * 4 + (c >> 5)) * 512 + ((kk & 7) * 32 + (c & 31)) * 2; }
__device__ __forceinline__ int v_rd_base(int lane) { return ((lane & 3) << 3) | (((lane >> 2) & 3) << 6) | (((lane >> 4) & 1) << 5) | (((lane >> 5) & 1) << 8); }
constexpr int v_rd_off(int d0, int ks, int half) { return d0 * 512 + ks * 4096 + half * 2048; }
__device__ __forceinline__ int crow(int r, int hi) { return (r & 3) + 8 * (r >> 2) + 4 * hi; }
__device__ __forceinline__ unsigned cvtpk(float lo, float hi) {
    unsigned r; asm volatile("v_cvt_pk_bf16_f32 %0, %1, %2" : "=v"(r) : "v"(lo), "v"(hi)); return r;
}
__device__ __forceinline__ bf16x8 pack8(f32x4 a, f32x4 b) {
    u32x4 w = {cvtpk(a[0], a[1]), cvtpk(a[2], a[3]), cvtpk(b[0], b[1]), cvtpk(b[2], b[3])};
    return *reinterpret_cast<bf16x8*>(&w);
}
template <class T> __device__ __forceinline__ bf16x8 load8(const T* p) {
    if constexpr (same_t<T, float>::v) { return pack8(*(const f32x4*)p, *(const f32x4*)(p + 4)); }
    else { return *reinterpret_cast<const bf16x8*>(p); }
}
__device__ __forceinline__ void mask_tile(f32x16& p0, f32x16& p1, int dq, unsigned W) {
    const float NEG = -__builtin_inff();
#pragma unroll
    for (int r = 0; r < 16; ++r) {
        const int c = (r & 3) + 8 * (r >> 2);
        if ((unsigned)(dq - c) >= W) p0[r] = NEG;
        if ((unsigned)(dq - c - 32) >= W) p1[r] = NEG;
    }
}
__device__ __forceinline__ void partialSM(f32x16& p0, f32x16& p1, float& m_reg, float& mn, float& alpha) {
    float pmax = p0[0]; for (int r = 1; r < 16; ++r) pmax = fmaxf(pmax, p0[r]); for (int r = 0; r < 16; ++r) pmax = fmaxf(pmax, p1[r]);
    { auto rr = __builtin_amdgcn_permlane32_swap(__float_as_uint(pmax), __float_as_uint(pmax), false, false);
      pmax = fmaxf(__uint_as_float(rr[0]), __uint_as_float(rr[1])); }
    constexpr float C2 = 1.4426950408889634f * SCALE;
    if (__builtin_expect(__all((pmax - m_reg) * SCALE <= THR), 1)) { mn = m_reg; alpha = 1.f; }
    else { mn = fmaxf(m_reg, pmax); alpha = __builtin_amdgcn_exp2f((m_reg - mn) * C2); m_reg = mn; }
    const float mnL = -mn * C2;
    for (int r = 0; r < 16; ++r) p0[r] = fmaf(p0[r], C2, mnL); for (int r = 0; r < 16; ++r) p1[r] = fmaf(p1[r], C2, mnL);
    for (int r = 0; r < 16; ++r) p0[r] = __builtin_amdgcn_exp2f(p0[r]);
}
__device__ __forceinline__ void finishSM(f32x16& p0, f32x16& p1, float alpha, float& l_reg, bf16x8& pa0, bf16x8& pa1, bf16x8& pa2, bf16x8& pa3) {
    for (int r = 0; r < 16; ++r) p1[r] = __builtin_amdgcn_exp2f(p1[r]);
    float ps = 0; for (int r = 0; r < 16; ++r) ps += p0[r]; for (int r = 0; r < 16; ++r) ps += p1[r];
    { auto rr = __builtin_amdgcn_permlane32_swap(__float_as_uint(ps), __float_as_uint(ps), false, false);
      ps = __uint_as_float(rr[0]) + __uint_as_float(rr[1]); }
    l_reg = l_reg * alpha + ps;
#define PK4(P, B_, OUT) do { unsigned a0 = cvtpk(P[B_+0], P[B_+1]), a1 = cvtpk(P[B_+2], P[B_+3]);                          \
        unsigned b0 = cvtpk(P[B_+4], P[B_+5]), b1 = cvtpk(P[B_+6], P[B_+7]);                                             \
        auto r0 = __builtin_amdgcn_permlane32_swap(a0, b0, false, false); auto r1 = __builtin_amdgcn_permlane32_swap(a1, b1, false, false); \
        u32x4 w = {r0[0], r1[0], r0[1], r1[1]}; OUT = *reinterpret_cast<bf16x8*>(&w); } while (0)
    PK4(p0, 0, pa0); PK4(p0, 8, pa1); PK4(p1, 0, pa2); PK4(p1, 8, pa3);
#undef PK4
}
template <int KB, bool SK>
__device__ __forceinline__ void qkt(f32x16& p0, f32x16& p1, const char* K_lds, int r32, int hi, const bf16x8* qr, bool act) {
    if (SK && !act) { const float NEG = -__builtin_inff();
#pragma unroll
        for (int r = 0; r < 16; ++r) { p0[r] = NEG; p1[r] = NEG; } return; }
    p0 = f32x16{}; p1 = f32x16{};
    const char* kb[4];
#pragma unroll
    for (int dd = 0; dd < 4; ++dd) kb[dd] = K_lds + KB * SHM_K + KSWZ(r32, (dd * 16 + hi * 8) * 2);
#pragma unroll
    for (int d0 = 0; d0 < 8; ++d0) { const char* a = kb[d0 & 3] + (d0 >> 2) * 128;
        bf16x8 b0 = *reinterpret_cast<const bf16x8*>(a);
        bf16x8 b1 = *reinterpret_cast<const bf16x8*>(a + 32 * 256);
        p0 = MFMA32B(b0, qr[d0], p0, 0, 0, 0);
        p1 = MFMA32B(b1, qr[d0], p1, 0, 0, 0); }
}
template <int VB, bool SK>
__device__ __forceinline__ void pv_tile(f32x16* o, int vb0, bf16x8 pa0, bf16x8 pa1, bf16x8 pa2, bf16x8 pa3, bool act) {
    if (SK && !act) return;
#define TRRD(dst, off) asm volatile("ds_read_b64_tr_b16 %0, %1 offset:%2" : "=&v"(dst) : "v"(vb0), "i"(off) : "memory")
#define PV_D0(d0) do { s16x4 l0, l1, l2, l3, h0, h1, h2, h3; constexpr int b_ = VB * SHM_V + v_rd_off(d0, 0, 0);     \
        TRRD(l0, b_); TRRD(h0, b_ + 2048); TRRD(l1, b_ + 4096); TRRD(h1, b_ + 6144); TRRD(l2, b_ + 8192); TRRD(h2, b_ + 10240); TRRD(l3, b_ + 12288); TRRD(h3, b_ + 14336); \
        asm volatile("s_waitcnt lgkmcnt(0)" ::: "memory"); SBAR();                 \
        o[d0] = MFMA32B(pa0, (bf16x8){l0[0], l0[1], l0[2], l0[3], h0[0], h0[1], h0[2], h0[3]}, o[d0], 0, 0, 0);   \
        o[d0] = MFMA32B(pa1, (bf16x8){l1[0], l1[1], l1[2], l1[3], h1[0], h1[1], h1[2], h1[3]}, o[d0], 0, 0, 0);   \
        o[d0] = MFMA32B(pa2, (bf16x8){l2[0], l2[1], l2[2], l2[3], h2[0], h2[1], h2[2], h2[3]}, o[d0], 0, 0, 0);   \
        o[d0] = MFMA32B(pa3, (bf16x8){l3[0], l3[1], l3[2], l3[3], h3[0], h3[1], h3[2], h3[3]}, o[d0], 0, 0, 0); } while (0)
    PV_D0(0); PV_D0(1); PV_D0(2); PV_D0(3);
#undef PV_D0
#undef TRRD
}

template <class TIn, class TOut> struct BlockRef { const TIn* Q; const TIn* K; const TIn* V; TOut* O; int P0; };
template <class TIn> struct Seam {
    bf16x8 qr[8];
    bf16x8 st_v0, st_v1, st_k0, st_k1; f32x4 sf0, sf1, sf2, sf3;
    f32x4 tq[16];
};
__device__ __forceinline__ int swa_jlo(int P0, int W) { const int lowk = P0 - W + 1; return lowk > 0 ? lowk / KVBLK : 0; }
#define ROW(p, k0, rr) ((p) + (size_t)((k0) + (rr)) * D + sc)
#define VMW() asm volatile("s_waitcnt vmcnt(0)" ::: "memory")
#define VMWN(n) asm volatile("s_waitcnt vmcnt(%0)" :: "i"(n) : "memory")
#define SLOAD_H(Kp, Vp, k0) do { S.st_v0 = load8<TIn>(ROW(Vp, k0, sr)); S.st_v1 = load8<TIn>(ROW(Vp, k0, 32 + sr));              \
                         S.st_k0 = load8<TIn>(ROW(Kp, k0, sr)); S.st_k1 = load8<TIn>(ROW(Kp, k0, 32 + sr)); } while (0)
#define SWRITE_HK(bf) do { *(bf16x8*)(K_lds + (bf) * SHM_K + kws) = S.st_k0; *(bf16x8*)(K_lds + (bf) * SHM_K + kws + 32 * 256) = S.st_k1; } while (0)
#define SWRITE_HV(bf) do { *(bf16x8*)(V_lds + (bf) * SHM_V + vst0) = S.st_v0; *(bf16x8*)(V_lds + (bf) * SHM_V + vst1) = S.st_v1; } while (0)
#define SWRITE_H(bf) do { SWRITE_HV(bf); SWRITE_HK(bf); } while (0)
#define SLOAD_F(p, k0) do { S.sf0 = *(const f32x4*)ROW(p, k0, sr); S.sf1 = *(const f32x4*)(ROW(p, k0, sr) + 4);                \
                            S.sf2 = *(const f32x4*)ROW(p, k0, 32 + sr); S.sf3 = *(const f32x4*)(ROW(p, k0, 32 + sr) + 4); } while (0)
#define SWRITE_KF(bf) do { *(bf16x8*)(K_lds + (bf) * SHM_K + kws) = pack8(S.sf0, S.sf1); *(bf16x8*)(K_lds + (bf) * SHM_K + kws + 32 * 256) = pack8(S.sf2, S.sf3); } while (0)
#define SWRITE_VF(bf) do { *(bf16x8*)(V_lds + (bf) * SHM_V + vst0) = pack8(S.sf0, S.sf1); *(bf16x8*)(V_lds + (bf) * SHM_V + vst1) = pack8(S.sf2, S.sf3); } while (0)
template <class TIn, class TOut>
__device__ __forceinline__ void causal_swa_prime(const BlockRef<TIn, TOut>& cur, int W, char* lds, Seam<TIn>& S) {
    constexpr bool F32 = same_t<TIn, float>::v;
    const int tid = threadIdx.x, wid = __builtin_amdgcn_readfirstlane(tid >> 6), lane = tid & 63, r32 = lane & 31, hi = lane >> 5;
    const int sr = tid >> 4, sc = (tid & 15) * 8, kws = KSWZ(sr, sc * 2); char* K_lds = lds + 2 * SHM_V;
    const int kb0 = swa_jlo(cur.P0, W) * KVBLK;
    for (int d0 = 0; d0 < 8; ++d0) S.qr[d0] = load8<TIn>(cur.Q + (size_t)(wid * QBLK + r32) * D + d0 * 16 + hi * 8);
    if constexpr (F32) { SLOAD_F((const float*)cur.K, kb0); VMW(); SWRITE_KF(0); SBAR(); SLOAD_F((const float*)cur.V, kb0); }
    else { SLOAD_H(cur.K, cur.V, kb0); VMW(); SWRITE_HK(0); }
    __syncthreads();
}
template <class TIn, class TOut>
__device__ __forceinline__ void causal_swa_block(const BlockRef<TIn, TOut>& cur, const BlockRef<TIn, TOut>& nxt, int skv, int W, char* lds, Seam<TIn>& S) {
    constexpr bool F32 = same_t<TIn, float>::v;
    const int tid = threadIdx.x, wid = __builtin_amdgcn_readfirstlane(tid >> 6), lane = tid & 63, r32 = lane & 31, hi = lane >> 5;
    const int j_lo = swa_jlo(cur.P0, W);
    int j_hi = (cur.P0 + QB - 1) / KVBLK + 1; if (j_hi > skv / KVBLK) j_hi = skv / KVBLK;
    const int NT = j_hi - j_lo;
    const int kbn = swa_jlo(nxt.P0, W) * KVBLK;
    const int qlo = cur.P0 + wid * QBLK, qm = qlo + r32 - 4 * hi;
    char* V_lds = lds; char* K_lds = lds + 2 * SHM_V;
    float* ws = (float*)(lds + 2 * SHM_V + 2 * SHM_K) + wid * 64; float* li_l = ws, * al_l = ws + 32;
    float m_reg = -1e30f, l_reg = 0; f32x16 o[4] = {};
    const int sr = tid >> 4, sc = (tid & 15) * 8, vst0 = v_st(sr, sc), vst1 = v_st(32 + sr, sc), kws = KSWZ(sr, sc * 2);
    const int vb0 = (int)(uintptr_t)V_lds + v_rd_base(lane);
    const TIn* Kh = cur.K; const TIn* Vh = cur.V;
#define RESC(a) do { if (__any((a) < 1.f)) { if (hi == 0) al_l[r32] = (a); asm volatile("s_waitcnt lgkmcnt(0)" ::: "memory");              \
                     for (int d_ = 0; d_ < 4; ++d_) for (int r = 0; r < 16; ++r) o[d_][r] *= al_l[crow(r, hi)]; } } while (0)
#define KBASE(t) ((j_lo + (t)) * KVBLK)
#define ACT(t) (KBASE(t) <= qlo + QBLK - 1 && KBASE(t) + KVBLK - 1 >= qlo - W + 1)
#define MASKT(P0_, P1_, t) do { const int kb_ = KBASE(t); if ((!SK || ACT(t)) && (kb_ + KVBLK - 1 > qlo || kb_ <= qlo + QBLK - 1 - W)) mask_tile(P0_, P1_, qm - kb_, (unsigned)W); } while (0)
    constexpr int NQL = F32 ? 16 : 8;
    constexpr bool SK = WSKIP && !F32;
#define SEAM_K0() do { VMWN(NQL); if constexpr (F32) { SWRITE_KF(0); SBAR(); SLOAD_F((const float*)nxt.V, kbn); } else { SWRITE_HK(0); } SBAR(); } while (0)
    f32x16 pA0, pA1, pB0, pB1; float mnA, mnB, alA, alB; bf16x8 pa0, pa1, pa2, pa3;
    if constexpr (F32) { VMW(); SWRITE_VF(0); SBAR(); } else { SWRITE_HV(0); SBAR(); }
    if (NT > 1) { if constexpr (F32) SLOAD_F((const float*)Kh, KBASE(1)); else SLOAD_H(Kh, Vh, KBASE(1)); }
    SBAR(); qkt<0, SK>(pA0, pA1, K_lds, r32, hi, S.qr, ACT(0));
    if constexpr (F32) { if (NT > 1) { VMW(); SWRITE_KF(1); SBAR(); SLOAD_F((const float*)Vh, KBASE(1)); } }
    MASKT(pA0, pA1, 0); partialSM(pA0, pA1, m_reg, mnA, alA);
    if (NT > 1) { VMW(); if constexpr (F32) { SWRITE_VF(1); SBAR(); if (NT > 2) SLOAD_F((const float*)Kh, KBASE(2)); } else SWRITE_H(1); }
    __syncthreads();
#define HALF_STEP(PX0, PX1, mnX, alX, PY0, PY1, alY, t, KB, VB, SB) do {                                                      \
        SBAR(); qkt<KB, SK>(PX0, PX1, K_lds, r32, hi, S.qr, ACT(t));                                             \
        finishSM(PY0, PY1, alY, l_reg, pa0, pa1, pa2, pa3); SBAR();                                                           \
        if ((t) + 1 < NT) { if constexpr (F32) { VMW(); SWRITE_KF(SB); SBAR(); SLOAD_F((const float*)Vh, KBASE((t) + 1)); }  \
                            else { SLOAD_H(Kh, Vh, KBASE((t) + 1)); } SBAR(); }                                               \
        pv_tile<VB, SK>(o, vb0, pa0, pa1, pa2, pa3, ACT((t) - 1)); MASKT(PX0, PX1, (t)); partialSM(PX0, PX1, m_reg, mnX, alX);                                        \
        __syncthreads();                                                                                                      \
        if ((t) + 1 < NT) { VMW(); if constexpr (F32) { SWRITE_VF(SB); SBAR(); if ((t) + 2 < NT) SLOAD_F((const float*)Kh, KBASE((t) + 2)); } \
                            else { SWRITE_H(SB); } }                                                                          \
        RESC(alX); __syncthreads(); } while (0)
    for (int t = 1; t + 1 < NT; t += 2) {
        HALF_STEP(pB0, pB1, mnB, alB, pA0, pA1, alA, t, 1, 0, 0);
        HALF_STEP(pA0, pA1, mnA, alA, pB0, pB1, alB, t + 1, 0, 1, 1);
    }
    const bool even = (NT & 1) == 0;
    if (even) { SBAR(); qkt<1, SK>(pB0, pB1, K_lds, r32, hi, S.qr, ACT(NT - 1)); SBAR(); }
#define QROW(e) (nxt.Q + (size_t)(wid * QBLK + r32) * D + ((e) >> 1) * 16 + hi * 8 + ((e) & 1) * 4)
    if constexpr (F32) { SLOAD_F((const float*)nxt.K, kbn); SBAR();
#pragma unroll
        for (int e = 0; e < 8; ++e) S.tq[e] = *(const f32x4*)QROW(e); }
    else { SLOAD_H(nxt.K, nxt.V, kbn); SBAR();
#pragma unroll
        for (int d0 = 0; d0 < 8; ++d0) S.qr[d0] = load8<TIn>(nxt.Q + (size_t)(wid * QBLK + r32) * D + d0 * 16 + hi * 8); }
    SBAR();
    finishSM(pA0, pA1, alA, l_reg, pa0, pa1, pa2, pa3); SBAR();
    if constexpr (F32) {
#pragma unroll
        for (int e = 8; e < 16; ++e) S.tq[e] = *(const f32x4*)QROW(e); SBAR(); }
#undef QROW
    pv_tile<0, SK>(o, vb0, pa0, pa1, pa2, pa3, ACT(even ? NT - 2 : NT - 1));
    if (even) { MASKT(pB0, pB1, NT - 1); partialSM(pB0, pB1, m_reg, mnB, alB); __syncthreads(); RESC(alB);
        finishSM(pB0, pB1, alB, l_reg, pa0, pa1, pa2, pa3); SBAR(); pv_tile<1, SK>(o, vb0, pa0, pa1, pa2, pa3, ACT(NT - 1)); }
    SBAR(); SEAM_K0();
    if (hi == 0) li_l[r32] = l_reg; asm volatile("s_waitcnt lgkmcnt(0)" ::: "memory");
    float rli[16];
#pragma unroll
    for (int r = 0; r < 16; ++r) rli[r] = __builtin_amdgcn_rcpf(li_l[crow(r, hi)]);
    TOut* Ow = cur.O + (size_t)(wid * QBLK) * OLD;
#pragma unroll
    for (int r = 0; r < 16; ++r) { const int orow = crow(r, hi);
#pragma unroll
        for (int d0 = 0; d0 < 4; ++d0) { const float v = o[d0][r] * rli[r];
            if constexpr (same_t<TOut, float>::v) { Ow[(size_t)orow * OLD + d0 * 32 + r32] = v; }
            else { const float vn = __shfl_xor(v, 1);
                   if ((r32 & 1) == 0) *(unsigned*)(Ow + (size_t)orow * OLD + d0 * 32 + r32) = cvtpk(v, vn); } } }
    if constexpr (F32) {
#pragma unroll
        for (int d0 = 0; d0 < 8; ++d0) S.qr[d0] = pack8(S.tq[2 * d0], S.tq[2 * d0 + 1]); }
    __syncthreads();
#undef RESC
#undef KBASE
#undef ACT
#undef MASKT
#undef SEAM_K0
#undef HALF_STEP
}
#undef ROW
#undef VMW
#undef VMWN
#undef SLOAD_H
#undef SWRITE_HK
#undef SWRITE_HV
#undef SWRITE_H
#undef SLOAD_F
#undef SWRITE_KF
#undef SWRITE_VF

}
#define LAS __attribute__((address_space(3)))
typedef unsigned short bf16_t;
typedef float f32x4 __attribute__((ext_vector_type(4)));
typedef float f32x2 __attribute__((ext_vector_type(2)));
typedef short bf16x8 __attribute__((ext_vector_type(8)));
typedef unsigned u32x4 __attribute__((ext_vector_type(4)));
typedef unsigned u32x2 __attribute__((ext_vector_type(2)));
constexpr int SEQ = 16384, DM = 1024, TT = 2 * SEQ, FF = 4096, NPH = 22;
constexpr size_t MiB = 1u << 20;
constexpr size_t WS_MOD = 0, WS_KVMOD = 128 * 1024, WS_ROPEC = 1 * MiB, WS_ROPES = 2 * MiB, WS_G = 3 * MiB, WS_BETA = 4 * MiB, WS_STATE = 5 * MiB, WS_GL = 6 * MiB;
constexpr size_t WS_WIN = 16 * MiB, WS_WAO = 24 * MiB, WS_WKV = 26 * MiB, WS_WQ = 30 * MiB, WS_WBO = 32 * MiB, WS_W1 = 34 * MiB, WS_W2 = 42 * MiB;
constexpr size_t WS_HB = 66 * MiB, WS_HB2 = 130 * MiB, WS_PREP = 66 * MiB, WS_O = 66 * MiB, WS_BIG = 256 * MiB, WS_HB3 = 448 * MiB, WS_END = 512 * MiB;
constexpr size_t CHUNK_ELEMS = 36864;
constexpr int LDS_BYTES = 147456;
constexpr float EPSN = 1e-6f;

__device__ __forceinline__ unsigned cvtpk(float lo, float hi) { h16x2 v = {(_Float16)lo, (_Float16)hi}; return __builtin_bit_cast(unsigned, v); }
__device__ __forceinline__ float bblo(unsigned w) { return __uint_as_float(w << 16); }
__device__ __forceinline__ float bbhi(unsigned w) { return __uint_as_float(w & 0xffff0000u); }
__device__ __forceinline__ float bflo(unsigned w) { return (float)__builtin_bit_cast(h16x2, w)[0]; }
__device__ __forceinline__ float bfhi(unsigned w) { return (float)__builtin_bit_cast(h16x2, w)[1]; }
__device__ __forceinline__ float wave_sum(float v) {
#pragma unroll
    for (int o = 1; o < 64; o <<= 1) v += __shfl_xor(v, o);
    return v;
}
__device__ __forceinline__ float siluf(float y) { return y * __builtin_amdgcn_rcpf(1.f + __expf(-y)); }
__device__ __forceinline__ bf16x8 pack8(f32x4 a, f32x4 b) { u32x4 w = {cvtpk(a[0], a[1]), cvtpk(a[2], a[3]), cvtpk(b[0], b[1]), cvtpk(b[2], b[3])}; return *reinterpret_cast<bf16x8*>(&w); }

struct Params { const float* in[23]; float* out; unsigned char* ws; int ph_lo, ph_hi; };

__device__ __forceinline__ void p0_transpose_item(const float* W, int K, int N, int ldw, bf16_t* WT, LAS float* scr, int item, int lane) {
    const int nblk = N / 32, kb = item / nblk, nb = item % nblk, k0 = 64 * kb, n0 = 32 * nb;
#pragma unroll 8
    for (int i = 0; i < 32; ++i) { const int kk = 2 * i + (lane >> 5); scr[kk * 33 + (lane & 31)] = W[(size_t)(k0 + kk) * ldw + n0 + (lane & 31)]; }
    asm volatile("s_waitcnt lgkmcnt(0)" ::: "memory");
    const int c = lane & 7;
#pragma unroll
    for (int j = 0; j < 4; ++j) { const int n = (lane >> 3) + 8 * j; const LAS float* s = scr + (8 * c) * 33 + n;
        u32x4 o; o.x = pkbf(s[0 * 33], s[1 * 33]); o.y = pkbf(s[2 * 33], s[3 * 33]); o.z = pkbf(s[4 * 33], s[5 * 33]); o.w = pkbf(s[6 * 33], s[7 * 33]);
        *(u32x4*)(WT + (size_t)(n0 + n) * K + k0 + 8 * c) = o; }
    asm volatile("s_waitcnt lgkmcnt(0)" ::: "memory");
}

__device__ __forceinline__ void p0_weights(const Params& p, LAS unsigned char* lds, int part, int wgr, int Gr, int tid) {
    const int wave = tid >> 6, lane = tid & 63;
    unsigned char* ws = p.ws;
    {
        LAS float* scr = (LAS float*)(lds + wave * 16384);
        const int gw = wgr * 8 + wave, NGW = Gr * 8;
        constexpr int I_IN = 16 * 128, I_SQ = 16 * 32, I_KV = 16 * 64, I_1 = 16 * 128, I_2 = 64 * 32;
        constexpr int NITEMS = I_IN + 3 * I_SQ + I_KV + 2 * I_1 + 2 * I_2;
        for (int it = (part ? I_IN : 0) + gw; it < (part ? NITEMS : I_IN); it += NGW) {
            int r = it;
            if (r < I_IN) { p0_transpose_item(p.in[6], 1024, 4096, 4112, (bf16_t*)(ws + WS_WIN), scr, r, lane); continue; } r -= I_IN;
            if (r < I_SQ) { p0_transpose_item(p.in[11], 1024, 1024, 1024, (bf16_t*)(ws + WS_WAO), scr, r, lane); continue; } r -= I_SQ;
            if (r < I_KV) { p0_transpose_item(p.in[15], 1024, 2048, 2048, (bf16_t*)(ws + WS_WKV), scr, r, lane); continue; } r -= I_KV;
            if (r < I_SQ) { p0_transpose_item(p.in[16], 1024, 1024, 1024, (bf16_t*)(ws + WS_WQ), scr, r, lane); continue; } r -= I_SQ;
            if (r < I_SQ) { p0_transpose_item(p.in[19], 1024, 1024, 1024, (bf16_t*)(ws + WS_WBO), scr, r, lane); continue; } r -= I_SQ;
            if (r < I_1) { p0_transpose_item(p.in[20], 1024, 4096, 4096, (bf16_t*)(ws + WS_W1), scr, r, lane); continue; } r -= I_1;
            if (r < I_1) { p0_transpose_item(p.in[20] + (size_t)1024 * 4096, 1024, 4096, 4096, (bf16_t*)(ws + WS_W1 + 16 * MiB), scr, r, lane); continue; } r -= I_1;
            if (r < I_2) { p0_transpose_item(p.in[21], 4096, 1024, 1024, (bf16_t*)(ws + WS_W2), scr, r, lane); continue; } r -= I_2;
            p0_transpose_item(p.in[21] + (size_t)4096 * 1024, 4096, 1024, 1024, (bf16_t*)(ws + WS_W2 + 16 * MiB), scr, r, lane);
        }
    }
}
__device__ __forceinline__ void p0_prologue(const Params& p, LAS unsigned char* lds, int wg, int G, int tid) {
    const int wave = tid >> 6, lane = tid & 63;
    unsigned char* ws = p.ws;
    p0_weights(p, lds, 0, wg, G, tid);
    __syncthreads();
    {
        float* rc = (float*)(ws + WS_ROPEC); float* rs = (float*)(ws + WS_ROPES);
        for (int idx = wg * 512 + tid; idx < SEQ * 16; idx += G * 512) {
            const int pos = idx >> 4, i = idx & 15;
            const double invf = exp(-(double)i * (1.0 / 16.0) * 13.122363377404328);
            const double rev = (double)pos * invf * 0.15915494309189535; const float fr = (float)(rev - floor(rev));
            rc[idx] = __builtin_amdgcn_cosf(fr); rs[idx] = __builtin_amdgcn_sinf(fr);
        }
    }
    {
        LAS float* cs = (LAS float*)lds;
        LAS float* part = (LAS float*)(lds + 8192);
        for (int i = tid; i < 2048; i += 512) cs[i] = siluf(p.in[1][i]);
        __syncthreads();
        for (int cb = wg; cb < 224; cb += G) {
            const float* W; int ld, n0; const float* bias; float* outp; int ostride;
            if (cb < 192) { const int l = cb / 96; n0 = (cb % 96) * 64; W = p.in[2] + (size_t)l * 1024 * 6144; ld = 6144; bias = p.in[3] + l * 6144; outp = (float*)(ws + WS_MOD) + l * 2 * 6144; ostride = 6144; }
            else { n0 = (cb - 192) * 64; W = p.in[12]; ld = 2048; bias = p.in[13]; outp = (float*)(ws + WS_KVMOD); ostride = 2048; }
            float a0 = 0.f, a1 = 0.f;
#pragma unroll 8
            for (int k = wave * 128; k < wave * 128 + 128; ++k) { const float w = W[(size_t)k * ld + n0 + lane]; a0 += cs[k] * w; a1 += cs[1024 + k] * w; }
            part[(wave * 2 + 0) * 64 + lane] = a0; part[(wave * 2 + 1) * 64 + lane] = a1;
            __syncthreads();
            if (tid < 128) { const int b = tid >> 6, c = tid & 63; float s = 0.f;
#pragma unroll
                for (int w = 0; w < 8; ++w) s += part[(w * 2 + b) * 64 + c];
                outp[b * ostride + n0 + c] = s + bias[n0 + c]; }
            __syncthreads();
        }
    }
}

__device__ __forceinline__ float reduce16_to_lane(const float (&acc)[16], int lane) {
    float r[8], s4[4], t2[2];
#pragma unroll
    for (int i = 0; i < 8; ++i) { const bool hi = lane & 1; const float keep = hi ? acc[2 * i + 1] : acc[2 * i], send = hi ? acc[2 * i] : acc[2 * i + 1]; r[i] = keep + __shfl_xor(send, 1); }
#pragma unroll
    for (int i = 0; i < 4; ++i) { const bool hi = lane & 2; const float keep = hi ? r[2 * i + 1] : r[2 * i], send = hi ? r[2 * i] : r[2 * i + 1]; s4[i] = keep + __shfl_xor(send, 2); }
#pragma unroll
    for (int i = 0; i < 2; ++i) { const bool hi = lane & 4; const float keep = hi ? s4[2 * i + 1] : s4[2 * i], send = hi ? s4[2 * i] : s4[2 * i + 1]; t2[i] = keep + __shfl_xor(send, 4); }
    const bool hi = lane & 8; float u = (hi ? t2[1] : t2[0]) + __shfl_xor(hi ? t2[0] : t2[1], 8);
    u += __shfl_xor(u, 16); u += __shfl_xor(u, 32);
    return u;
}
template <bool AB, bool SRC16>
__device__ __forceinline__ void modulate_phase(const Params& p, LAS unsigned char* lds, const void* src, const float* g, const float* shift, const float* scale, int bstride,
                                               bf16_t* dst, int wg, int G, int tid) {
    const int wave = tid >> 6, lane = tid & 63, gw = wg * 8 + wave, NGW = G * 8;
    LAS float* wab = (LAS float*)lds;
    if (AB) {
        const float* win = p.in[6];
        for (int idx = tid; idx < 16384; idx += 512) { const int k = idx >> 4, c = idx & 15; wab[c * 1024 + k] = win[(size_t)k * 4112 + 4096 + c]; }
        __syncthreads();
    }
    for (int b = 0; b < 2; ++b) {
        f32x4 gs[4], sh[4];
#pragma unroll
        for (int j = 0; j < 4; ++j) { const int c = 4 * lane + 256 * j; const f32x4 gv = *(const f32x4*)(g + c), sc = *(const f32x4*)(scale + b * bstride + c); gs[j] = gv * (sc + 1.f); sh[j] = *(const f32x4*)(shift + b * bstride + c); }
        for (int m = b * SEQ + gw; m < (b + 1) * SEQ; m += 2 * NGW) {
            const int m1 = (m + NGW < (b + 1) * SEQ) ? m + NGW : m;
            f32x4 v0[4], v1[4]; float s0 = 0.f, s1 = 0.f;
            if (SRC16) { const u32x2* xr0 = (const u32x2*)((const bf16_t*)src + (size_t)m * DM) + lane; const u32x2* xr1 = (const u32x2*)((const bf16_t*)src + (size_t)m1 * DM) + lane;
#pragma unroll
                for (int j = 0; j < 4; ++j) { const u32x2 a = xr0[64 * j], c2 = xr1[64 * j]; v0[j] = (f32x4){f16lo(a.x), f16hi(a.x), f16lo(a.y), f16hi(a.y)}; v1[j] = (f32x4){f16lo(c2.x), f16hi(c2.x), f16lo(c2.y), f16hi(c2.y)}; } }
            else { const f32x4* xr0 = (const f32x4*)((const float*)src + (size_t)m * DM) + lane; const f32x4* xr1 = (const f32x4*)((const float*)src + (size_t)m1 * DM) + lane;
#pragma unroll
                for (int j = 0; j < 4; ++j) { v0[j] = xr0[64 * j]; v1[j] = xr1[64 * j]; } }
#pragma unroll
            for (int j = 0; j < 4; ++j) { s0 += (v0[j].x * v0[j].x + v0[j].y * v0[j].y) + (v0[j].z * v0[j].z + v0[j].w * v0[j].w); s1 += (v1[j].x * v1[j].x + v1[j].y * v1[j].y) + (v1[j].z * v1[j].z + v1[j].w * v1[j].w); }
            const float rstd0 = rsqrtf(wave_sum(s0) * (1.f / DM) + EPSN), rstd1 = rsqrtf(wave_sum(s1) * (1.f / DM) + EPSN);
            u32x2* o0 = (u32x2*)(dst + (size_t)m * DM) + lane; u32x2* o1 = (u32x2*)(dst + (size_t)m1 * DM) + lane;
#pragma unroll
            for (int j = 0; j < 4; ++j) { v0[j] = v0[j] * rstd0 * gs[j] + sh[j]; v1[j] = v1[j] * rstd1 * gs[j] + sh[j];
                u32x2 w; w.x = pkbf(v0[j].x, v0[j].y); w.y = pkbf(v0[j].z, v0[j].w); o0[64 * j] = w; w.x = pkbf(v1[j].x, v1[j].y); w.y = pkbf(v1[j].z, v1[j].w); o1[64 * j] = w; }
            if (AB) {
                asm volatile("" ::: "memory");
                float acc0[16], acc1[16];
#pragma unroll
                for (int c = 0; c < 16; ++c) { float a0 = 0.f, a1 = 0.f;
#pragma unroll
                    for (int j = 0; j < 4; ++j) { const f32x4 w = *(const LAS f32x4*)(wab + c * 1024 + 4 * lane + 256 * j);
                        a0 += (v0[j].x * w.x + v0[j].y * w.y) + (v0[j].z * w.z + v0[j].w * w.w); a1 += (v1[j].x * w.x + v1[j].y * w.y) + (v1[j].z * w.z + v1[j].w * w.w); }
                    acc0[c] = a0; acc1[c] = a1; }
                const float u0 = reduce16_to_lane(acc0, lane), u1 = reduce16_to_lane(acc1, lane);
                if (lane < 16) { const int hl = lane & 7;
                    if (lane < 8) { const float al = -expf(p.in[8][hl]), db = p.in[9][hl];
                        const float x0 = u0 + db, x1 = u1 + db;
                        ((float*)(p.ws + WS_G))[(size_t)m * 8 + hl] = al * (fmaxf(x0, 0.f) + log1pf(expf(-fabsf(x0))));
                        ((float*)(p.ws + WS_G))[(size_t)m1 * 8 + hl] = al * (fmaxf(x1, 0.f) + log1pf(expf(-fabsf(x1))));
                    } else {
                        ((float*)(p.ws + WS_BETA))[(size_t)m * 8 + hl] = 1.f / (1.f + expf(-u0));
                        ((float*)(p.ws + WS_BETA))[(size_t)m1 * 8 + hl] = 1.f / (1.f + expf(-u1));
                    } }
            }
        }
    }
}
__device__ __forceinline__ void modulate2_phase(const bf16_t* src, const float* g1, const float* shift1, const float* scale1, int bs1, bf16_t* dst1,
                                                const float* g2, const float* shift2, const float* scale2, int bs2, bf16_t* dst2, int wg, int G, int tid) {
    const int wave = tid >> 6, lane = tid & 63, gw = wg * 8 + wave, NGW = G * 8;
    for (int b = 0; b < 2; ++b) {
        f32x4 gs1[4], sh1[4], gs2[4], sh2[4];
#pragma unroll
        for (int j = 0; j < 4; ++j) { const int c = 4 * lane + 256 * j;
            gs1[j] = *(const f32x4*)(g1 + c) * (*(const f32x4*)(scale1 + b * bs1 + c) + 1.f); sh1[j] = *(const f32x4*)(shift1 + b * bs1 + c);
            gs2[j] = *(const f32x4*)(g2 + c) * (*(const f32x4*)(scale2 + b * bs2 + c) + 1.f); sh2[j] = *(const f32x4*)(shift2 + b * bs2 + c); }
        for (int m = b * SEQ + gw; m < (b + 1) * SEQ; m += NGW) {
            const u32x2* xr = (const u32x2*)(src + (size_t)m * DM) + lane;
            f32x4 v[4]; float s = 0.f;
#pragma unroll
            for (int j = 0; j < 4; ++j) { const u32x2 t = xr[64 * j]; v[j] = (f32x4){f16lo(t.x), f16hi(t.x), f16lo(t.y), f16hi(t.y)}; s += (v[j].x * v[j].x + v[j].y * v[j].y) + (v[j].z * v[j].z + v[j].w * v[j].w); }
            const float rstd = rsqrtf(wave_sum(s) * (1.f / DM) + EPSN);
            u32x2* o1 = (u32x2*)(dst1 + (size_t)m * DM) + lane; u32x2* o2 = (u32x2*)(dst2 + (size_t)m * DM) + lane;
#pragma unroll
            for (int j = 0; j < 4; ++j) { const f32x4 xn = v[j] * rstd; const f32x4 a = xn * gs1[j] + sh1[j], c2 = xn * gs2[j] + sh2[j];
                u32x2 w; w.x = pkbf(a.x, a.y); w.y = pkbf(a.z, a.w); o1[64 * j] = w; w.x = pkbf(c2.x, c2.y); w.y = pkbf(c2.z, c2.w); o2[64 * j] = w; }
        }
    }
}
__device__ __forceinline__ void gate_phase(const float* o, const bf16_t* proj, const float* outg, bf16_t* dst, int wg, int G, int tid) {
    const int wave = tid >> 6, lane = tid & 63, gw = wg * 8 + wave, NGW = G * 8;
    const f32x4 gv = *(const f32x4*)(outg + ((4 * lane) & 127));
    for (int m = gw; m < TT; m += NGW) {
        const f32x4* xr = (const f32x4*)(o + (size_t)m * DM) + lane; const u32x2* zr = (const u32x2*)(proj + (size_t)m * 4096 + 3072) + lane;
        u32x2* o8 = (u32x2*)(dst + (size_t)m * DM) + lane;
#pragma unroll
        for (int j = 0; j < 4; ++j) { const f32x4 v = xr[64 * j]; const u32x2 zz = zr[64 * j];
            float s = (v.x * v.x + v.y * v.y) + (v.z * v.z + v.w * v.w);
#pragma unroll
            for (int ofs = 1; ofs < 32; ofs <<= 1) s += __shfl_xor(s, ofs);
            const float rstd = rsqrtf(s * (1.f / 128.f) + EPSN);
            const f32x4 r = v * rstd * gv;
            u32x2 w; w.x = pkbf(r.x * siluf(bflo(zz.x)), r.y * siluf(bfhi(zz.x))); w.y = pkbf(r.z * siluf(bflo(zz.y)), r.w * siluf(bfhi(zz.y))); o8[64 * j] = w; }
    }
}
__device__ __forceinline__ void combine_phase(const Params& p, const bf16_t* O, bf16_t* dst, int wg, int G, int tid) {
    const int wave = tid >> 6, lane = tid & 63, gw = wg * 8 + wave, NGW = G * 8;
    const float lam_init = 0.8f - 0.6f * 0.7408182206817179f;
    const float* lp = p.in[17];
    float d1 = lp[lane] * lp[128 + lane] + lp[64 + lane] * lp[192 + lane], d2 = lp[256 + lane] * lp[384 + lane] + lp[320 + lane] * lp[448 + lane];
    const float lam = expf(wave_sum(d1)) - expf(wave_sum(d2)) + lam_init;
    const f32x4 gv = *(const f32x4*)(p.in[18] + 4 * lane) * (1.f - lam_init);
    for (int m = gw; m < TT; m += NGW) {
        const u32x2* a = (const u32x2*)(O + (size_t)m * DM) + lane; const u32x2* b = (const u32x2*)(O + (size_t)(TT + m) * DM) + lane;
        u32x2* o8 = (u32x2*)(dst + (size_t)m * DM) + lane;
#pragma unroll
        for (int j = 0; j < 4; ++j) { const u32x2 x1 = a[64 * j], x2 = b[64 * j];
            f32x4 v = {bblo(x1.x) - lam * bblo(x2.x), bbhi(x1.x) - lam * bbhi(x2.x), bblo(x1.y) - lam * bblo(x2.y), bbhi(x1.y) - lam * bbhi(x2.y)};
            const float s = wave_sum((v.x * v.x + v.y * v.y) + (v.z * v.z + v.w * v.w));
            const float rstd = rsqrtf(s * (1.f / 256.f) + EPSN);
            v = v * rstd * gv; u32x2 w; w.x = pkbf(v.x, v.y); w.y = pkbf(v.z, v.w); o8[64 * j] = w; }
    }
}
__device__ __forceinline__ void final_phase(const bf16_t* xs, float* out, const float* g, int wg, int G, int tid) {
    const int wave = tid >> 6, lane = tid & 63, gw = wg * 8 + wave, NGW = G * 8;
    f32x4 gs[4];
#pragma unroll
    for (int j = 0; j < 4; ++j) gs[j] = *(const f32x4*)(g + 4 * lane + 256 * j);
    for (int m = gw; m < TT; m += NGW) {
        const u32x2* xr = (const u32x2*)(xs + (size_t)m * DM) + lane; f32x4* orow = (f32x4*)(out + (size_t)m * DM) + lane; f32x4 v[4]; float s = 0.f;
#pragma unroll
        for (int j = 0; j < 4; ++j) { const u32x2 t = xr[64 * j]; v[j] = (f32x4){f16lo(t.x), f16hi(t.x), f16lo(t.y), f16hi(t.y)}; s += (v[j].x * v[j].x + v[j].y * v[j].y) + (v[j].z * v[j].z + v[j].w * v[j].w); }
        const float rstd = rsqrtf(wave_sum(s) * (1.f / DM) + EPSN);
#pragma unroll
        for (int j = 0; j < 4; ++j) orow[64 * j] = v[j] * rstd * gs[j];
    }
}

template <int J> __device__ __forceinline__ void solve_load(f32x4 (&a)[16], const LAS float* AT) {
#pragma unroll
    for (int ib = (J + 1) / 4; ib < 16; ++ib) a[ib] = *(const LAS f32x4*)(AT + J * 68 + 4 * ib);
}
template <int J> __device__ __forceinline__ void solve_step(float (&x)[64], const f32x4 (&cur)[16], const LAS float* AT) {
    if constexpr (J < 63) {
        f32x4 nxt[16];
        if constexpr (J + 1 < 63) solve_load<J + 1>(nxt, AT);
#pragma unroll
        for (int ib = (J + 1) / 4; ib < 16; ++ib) {
#pragma unroll
            for (int e = 0; e < 4; ++e) { if (4 * ib + e > J) x[4 * ib + e] -= cur[ib][e] * x[J]; } }
        __builtin_amdgcn_sched_barrier(0);
        solve_step<J + 1>(x, nxt, AT);
    }
}
template <int J0, int J1> __device__ __forceinline__ void solve_range(float (&x)[64], const LAS float* AT) {
    f32x4 cur[16]; solve_load<J0>(cur, AT); solve_step<J0>(x, cur, AT);
}
constexpr int L_AT = 0, L_QS = 17408, L_KN = 34816, L_KF = 52224, L_VF = 84992, L_GC = 117760, L_BT = 118016, L_EG = 118272;
__device__ __forceinline__ void prep_phase(const Params& p, LAS unsigned char* lds, int q, int ufirst, int ustride, int ucnt, int tid_in) {
    const bf16_t* proj = (const bf16_t*)(p.ws + WS_BIG); const float* convw = p.in[7];
    const float* Gp = (const float*)(p.ws + WS_G); const float* Bp = (const float*)(p.ws + WS_BETA);
    LAS bf16_t* QS = (LAS bf16_t*)(lds + L_QS); LAS bf16_t* KN = (LAS bf16_t*)(lds + L_KN);
    LAS float* KF = (LAS float*)(lds + L_KF); LAS float* VF = (LAS float*)(lds + L_VF); LAS float* AT = (LAS float*)(lds + L_AT);
    LAS float* GC = (LAS float*)(lds + L_GC); LAS float* BT = (LAS float*)(lds + L_BT); LAS float* EG = (LAS float*)(lds + L_EG);
#pragma unroll 1
    for (int ui = 0; ui < ucnt; ++ui) { const int u = ufirst + ui * ustride;
        const int bh = u >> 6, nl = u & 63, b = bh >> 3, h = bh & 7, ng = q * 64 + nl;
        const size_t tb = (size_t)b * SEQ + (size_t)ng * 64;
        bf16_t* cb = (bf16_t*)(p.ws + WS_PREP) + (size_t)((q & 1) * 1024 + u) * CHUNK_ELEMS;
        int tid = tid_in; asm volatile("" : "+v"(tid));
        if (tid < 64) { const int lane = tid;
            float gv = Gp[(tb + lane) * 8 + h];
#pragma unroll
            for (int d = 1; d < 64; d <<= 1) { const float t = __shfl_up(gv, d); if (lane >= d) gv += t; }
            GC[lane] = gv; BT[lane] = Bp[(tb + lane) * 8 + h]; EG[lane] = __expf(gv);
            if (lane == 63) ((float*)(p.ws + WS_GL))[(q & 1) * 1024 + u] = __expf(gv);
        }
        __syncthreads();
        if (tid < 384) {
            const int cgi = tid % 48, rs = tid / 48, mat = cgi >> 4, c0 = (cgi & 15) * 8, r0 = rs * 8;
            const int ch = mat * 1024 + h * 128 + c0;
            float val[8][8];
            {
                f32x4 w[4][2];
#pragma unroll
                for (int j = 0; j < 4; ++j) { w[j][0] = *(const f32x4*)(convw + j * 3072 + ch); w[j][1] = *(const f32x4*)(convw + j * 3072 + ch + 4); }
                u32x4 raw[11];
#pragma unroll
                for (int rr = 0; rr < 11; ++rr) { const int sq = ng * 64 + r0 - 3 + rr; const bool ok = sq >= 0;
                    const bf16_t* sp = proj + ((size_t)b * SEQ + (ok ? sq : 0)) * 4096 + ch; u32x4 t = *(const u32x4*)sp; if (!ok) t = (u32x4){0u, 0u, 0u, 0u}; raw[rr] = t; }
#pragma unroll
                for (int r = 0; r < 8; ++r) { float ss = 0.f;
#pragma unroll
                    for (int e = 0; e < 8; ++e) { float a = 0.f;
#pragma unroll
                        for (int j = 0; j < 4; ++j) { const unsigned wd = raw[r + j][e >> 1]; const float xv = (e & 1) ? bfhi(wd) : bflo(wd); a += w[j][e >> 2][e & 3] * xv; }
                        const float y = siluf(a); val[r][e] = y; ss += y * y; }
                    ss += __shfl_xor(ss, 1); ss += __shfl_xor(ss, 2); ss += __shfl_xor(ss, 4); ss += __shfl_xor(ss, 8);
                    const float rstd = (mat < 2) ? rsqrtf(ss + EPSN) : 1.f;
#pragma unroll
                    for (int e = 0; e < 8; ++e) val[r][e] *= rstd; }
            }
            const float glast = GC[63];
#pragma unroll
            for (int r = 0; r < 8; ++r) { const int row = r0 + r;
                if (mat == 0) { const float eg = EG[row];
                    float q[8];
#pragma unroll
                    for (int e = 0; e < 8; ++e) q[e] = val[r][e] * 0.08838834764831845f;
                    u32x4 w = {cvtpk(q[0], q[1]), cvtpk(q[2], q[3]), cvtpk(q[4], q[5]), cvtpk(q[6], q[7])};
                    *(LAS u32x4*)(QS + row * 136 + c0) = w;
                    const int kb = c0 >> 5, j0 = c0 & 31, hi = j0 >> 4, q4 = (j0 & 15) >> 2;
                    bf16_t* d = cb + 8192 + row * 128 + 32 * kb + 8 * q4 + 4 * hi;
                    u32x2 g0 = {cvtpk(q[0] * eg, q[1] * eg), cvtpk(q[2] * eg, q[3] * eg)}, g1 = {cvtpk(q[4] * eg, q[5] * eg), cvtpk(q[6] * eg, q[7] * eg)};
                    *(u32x2*)d = g0; *(u32x2*)(d + 8) = g1;
                } else if (mat == 1) { const float be = BT[row] * EG[row]; const float kd = __expf(glast - GC[row]);
                    float k[8];
#pragma unroll
                    for (int e = 0; e < 8; ++e) { k[e] = val[r][e]; val[r][e] = k[e] * kd; }
                    u32x4 w = {cvtpk(k[0], k[1]), cvtpk(k[2], k[3]), cvtpk(k[4], k[5]), cvtpk(k[6], k[7])};
                    *(LAS u32x4*)(KN + row * 136 + c0) = w;
                    *(LAS f32x4*)(KF + row * 128 + c0) = (f32x4){k[0] * be, k[1] * be, k[2] * be, k[3] * be};
                    *(LAS f32x4*)(KF + row * 128 + c0 + 4) = (f32x4){k[4] * be, k[5] * be, k[6] * be, k[7] * be};
                } else { const float bt = BT[row];
                    *(LAS f32x4*)(VF + row * 128 + c0) = (f32x4){val[r][0] * bt, val[r][1] * bt, val[r][2] * bt, val[r][3] * bt};
                    *(LAS f32x4*)(VF + row * 128 + c0 + 4) = (f32x4){val[r][4] * bt, val[r][5] * bt, val[r][6] * bt, val[r][7] * bt};
                } }
            if (mat == 1) {
                const int jb = r0 >> 5, j0 = r0 & 31, hi = j0 >> 4, q4 = (j0 & 15) >> 2;
#pragma unroll
                for (int e = 0; e < 8; ++e) { bf16_t* d = cb + 16384 + (c0 + e) * 64 + 32 * jb + 8 * q4 + 4 * hi;
                    u32x2 a0 = {cvtpk(val[0][e], val[1][e]), cvtpk(val[2][e], val[3][e])}, a1 = {cvtpk(val[4][e], val[5][e]), cvtpk(val[6][e], val[7][e])};
                    *(u32x2*)d = a0; *(u32x2*)(d + 8) = a1; }
            }
        }
        __syncthreads();
        asm volatile("" : "+v"(tid));
        {
            const int fr = tid & 15, fq = (tid >> 4) & 3, wave = __builtin_amdgcn_readfirstlane(tid >> 6);
#pragma unroll
            for (int tt = 0; tt < 2; ++tt) { const int tile = wave * 2 + tt, mt = tile >> 2, nt = tile & 3;
                if (mt >= nt) {
                    f32x4 acc = {0.f, 0.f, 0.f, 0.f};
#pragma unroll
                    for (int ks = 0; ks < 4; ++ks) { const bf16x8 a = *(const LAS bf16x8*)(KN + (16 * mt + fr) * 136 + 32 * ks + 8 * fq), bb = *(const LAS bf16x8*)(KN + (16 * nt + fr) * 136 + 32 * ks + 8 * fq);
                        acc = MFMA16(a, bb, acc, 0, 0, 0); }
                    const int j = 16 * nt + fr; const float gj = GC[j]; f32x4 o;
#pragma unroll
                    for (int e = 0; e < 4; ++e) { const int i = 16 * mt + 4 * fq + e; o[e] = (i > j) ? BT[i] * acc[e] * __expf(GC[i] - gj) : 0.f; }
                    *(LAS f32x4*)(AT + j * 68 + 16 * mt + 4 * fq) = o;
                }
                u32x2 w = {0u, 0u};
                const int i = 16 * nt + fr;
                if (nt >= mt) {
                    f32x4 acc = {0.f, 0.f, 0.f, 0.f};
#pragma unroll
                    for (int ks = 0; ks < 4; ++ks) { const bf16x8 a = *(const LAS bf16x8*)(KN + (16 * mt + fr) * 136 + 32 * ks + 8 * fq), bb = *(const LAS bf16x8*)(QS + (16 * nt + fr) * 136 + 32 * ks + 8 * fq);
                        acc = MFMA16(a, bb, acc, 0, 0, 0); }
                    const float gi = GC[i]; float o[4];
#pragma unroll
                    for (int e = 0; e < 4; ++e) { const int j = 16 * mt + 4 * fq + e; o[e] = (i >= j) ? acc[e] * __expf(gi - GC[j]) : 0.f; }
                    w.x = cvtpk(o[0], o[1]); w.y = cvtpk(o[2], o[3]);
                }
                *(u32x2*)(cb + 32768 + i * 64 + 32 * (mt >> 1) + 8 * fq + 4 * (mt & 1)) = w;
            }
        }
        __syncthreads();
        asm volatile("" : "+v"(tid));
        if (tid < 256) {
            LAS float* MF = (tid < 128) ? (VF + tid) : (KF + (tid - 128));
            float x[64];
#pragma unroll
            for (int r = 0; r < 64; ++r) x[r] = MF[r * 128];
            solve_range<0, 63>(x, AT);
#pragma unroll
            for (int r = 0; r < 64; ++r) MF[r * 128] = x[r];
        }
        __syncthreads();
        asm volatile("" : "+v"(tid));
        { const int dv = tid & 127, rseg = tid >> 7; float uu[16];
#pragma unroll
            for (int r = 0; r < 16; ++r) uu[r] = VF[(16 * rseg + r) * 128 + dv];
            u32x4 w0 = {cvtpk(uu[0], uu[1]), cvtpk(uu[2], uu[3]), cvtpk(uu[4], uu[5]), cvtpk(uu[6], uu[7])}, w1 = {cvtpk(uu[8], uu[9]), cvtpk(uu[10], uu[11]), cvtpk(uu[12], uu[13]), cvtpk(uu[14], uu[15])};
            bf16_t* d = cb + 24576 + dv * 64 + 16 * rseg; *(u32x4*)d = w0; *(u32x4*)(d + 8) = w1; }
        { const int r = tid >> 3, cgp = tid & 7, kb = cgp >> 1, hi = cgp & 1;
#pragma unroll
            for (int g = 0; g < 4; ++g) { const f32x4 v = *(const LAS f32x4*)(KF + r * 128 + 16 * cgp + 4 * g); u32x2 w = {cvtpk(v.x, v.y), cvtpk(v.z, v.w)};
                *(u32x2*)(cb + r * 128 + 32 * kb + 8 * g + 4 * hi) = w; } }
        __syncthreads();
    }
}

constexpr int SC_W = 0, SC_QG = 17408, SC_KD = 34816, SC_QK = 53248, SC_UT = 62464, SC_BUF = 64768;
__device__ __forceinline__ void scan_piece(int q, int dv0, int& src, int& dst) {
    if (q < 2048) { const int r = q >> 10, w = q & 1023; src = q * 16; dst = r * 17408 + (w >> 4) * 272 + (w & 15) * 16; }
    else if (q < 3072) { const int w = q - 2048; src = q * 16; dst = SC_KD + (w >> 3) * 144 + (w & 7) * 16; }
    else if (q < 3584) { const int w = q - 3072; src = 65536 + w * 16; dst = SC_QK + (w >> 3) * 144 + (w & 7) * 16; }
    else { const int w = q - 3584; src = 49152 + (dv0 + (w >> 3)) * 128 + (w & 7) * 16; dst = SC_UT + (w >> 3) * 144 + (w & 7) * 16; }
}
constexpr int SC_XV = 131584, SC_XS = 133632;
__device__ __forceinline__ void scan_phase(const Params& p, LAS unsigned char* lds, int q, int wg, int tid) {
    if (wg >= 128) return;
    const int lane = tid & 63, fr = lane & 15, fq = lane >> 4, w = __builtin_amdgcn_readfirstlane(tid >> 6);
    const int xcd = wg & 7, jj = wg >> 3, bh = xcd * 2 + (jj >> 3), sl = jj & 7, dv0 = 16 * sl, b = bh >> 3, h = bh & 7;
    const bool helper = tid >= 256;
    const unsigned char* rec0 = p.ws + WS_PREP + (size_t)((q & 1) * 1024 + bh * 64) * CHUNK_ELEMS * 2;
#define SC_BAR() do { asm volatile("s_waitcnt lgkmcnt(0)" ::: "memory"); __builtin_amdgcn_s_barrier(); asm volatile("" ::: "memory"); } while (0)
    if (helper) {
        const int t = tid - 256, t7 = t & 127;
        const unsigned so = (unsigned)t * 16u, so14 = (unsigned)t7 * 16u;
        const int d0 = (t >> 4) * 272 + (t & 15) * 16, d1 = (t >> 3) * 144 + (t & 7) * 16, d14 = (t7 >> 3) * 144 + (t7 & 7) * 16;
        u32x4 R0[15], R1[15], R2[15];
#define SC_SRC(i) ((i) < 12 ? (i) * 4096 : (i) < 14 ? (i) * 4096 + 16384 : 49152 + dv0 * 128)
#define SC_DST(i) ((i) < 8 ? d0 + ((i) >> 2) * 17408 + ((i) & 3) * 4352 : (i) < 12 ? d1 + SC_KD + ((i) - 8) * 4608 : (i) < 14 ? d1 + SC_QK + ((i) - 12) * 4608 : d14 + SC_UT)
#define SC_LDH(R, c) do { const unsigned char* rp_ = rec0 + (size_t)(c) * (CHUNK_ELEMS * 2); _Pragma("unroll") for (int i = 0; i < 15; ++i) R[i] = *(const u32x4*)(rp_ + SC_SRC(i) + (i == 14 ? so14 : so)); } while (0)
#define SC_STH(R, bf) do { _Pragma("unroll") for (int i = 0; i < 15; ++i) *(LAS u32x4*)(lds + (bf) * SC_BUF + SC_DST(i)) = R[i]; } while (0)
        SC_LDH(R0, 0); SC_LDH(R1, 1); SC_LDH(R2, 2); SC_STH(R0, 0); SC_BAR();
#pragma unroll 1
        for (int n = 0; n < 60; n += 3) {
            SC_LDH(R0, n + 3); SC_STH(R1, (n + 1) & 1); SC_BAR(); SC_BAR();
            SC_LDH(R1, n + 4); SC_STH(R2, (n + 2) & 1); SC_BAR(); SC_BAR();
            SC_LDH(R2, n + 5); SC_STH(R0, (n + 3) & 1); SC_BAR(); SC_BAR();
        }
        SC_LDH(R0, 63); SC_STH(R1, 1); SC_BAR(); SC_BAR();
        SC_STH(R2, 0); SC_BAR(); SC_BAR();
        SC_STH(R0, 1); SC_BAR(); SC_BAR();
        SC_BAR(); SC_BAR();
#undef SC_LDH
#undef SC_STH
#undef SC_SRC
#undef SC_DST
    } else {
        f32x4* st = (f32x4*)(p.ws + WS_STATE) + (size_t)wg * 8 * 64 + lane;
        const float* GL = (const float*)(p.ws + WS_GL) + (q & 1) * 1024 + bh * 64;
        float* O = p.out;
        const float glr0 = GL[lane];
        f32x4 S0 = q ? st[(2 * w) * 64] : (f32x4){0.f, 0.f, 0.f, 0.f}, S1 = q ? st[(2 * w + 1) * 64] : (f32x4){0.f, 0.f, 0.f, 0.f};
        LAS unsigned char* XV = lds + SC_XV; LAS unsigned char* XS = lds + SC_XS;
        *(LAS bf16x8*)(XS + w * 1024 + lane * 16) = pack8(S0, S1);
        SC_BAR();
        const int aw = (16 * w + fr) * 272 + fq * 16, ak = (16 * w + fr) * 144 + fq * 16, akd = (32 * w + fr) * 144 + fq * 16;
#pragma unroll 1
        for (int n = 0; n < 64; ++n) {
            LAS unsigned char* B_ = lds + (n & 1) * SC_BUF;
            const float gl = __uint_as_float((unsigned)__builtin_amdgcn_readlane((int)__float_as_uint(glr0), n));
            bf16x8 Sb[4], Wf[4], QGf[4], QKf[2], KDf[2][2];
#pragma unroll
            for (int ks = 0; ks < 4; ++ks) { Sb[ks] = *(const LAS bf16x8*)(XS + ks * 1024 + lane * 16); Wf[ks] = *(const LAS bf16x8*)(B_ + SC_W + aw + ks * 64); }
            const u32x2 uw = *(const LAS u32x2*)(B_ + SC_UT + fr * 144 + w * 32 + fq * 8);
#pragma unroll
            for (int ks = 0; ks < 4; ++ks) QGf[ks] = *(const LAS bf16x8*)(B_ + SC_QG + aw + ks * 64);
            __builtin_amdgcn_sched_barrier(0);
#pragma unroll
            for (int k2 = 0; k2 < 2; ++k2) { QKf[k2] = *(const LAS bf16x8*)(B_ + SC_QK + ak + k2 * 64); KDf[0][k2] = *(const LAS bf16x8*)(B_ + SC_KD + akd + k2 * 64); KDf[1][k2] = *(const LAS bf16x8*)(B_ + SC_KD + akd + 2304 + k2 * 64); }
            f32x4 acc = {0.f, 0.f, 0.f, 0.f}, oa = {0.f, 0.f, 0.f, 0.f};
#pragma unroll
            for (int ks = 0; ks < 4; ++ks) { acc = MFMA16(Wf[ks], Sb[ks], acc); oa = MFMA16(QGf[ks], Sb[ks], oa); }
            const f32x4 vn = (f32x4){bflo(uw.x), bfhi(uw.x), bflo(uw.y), bfhi(uw.y)} - acc;
            { u32x2 pv = {cvtpk(vn[0], vn[1]), cvtpk(vn[2], vn[3])}; *(LAS u32x2*)(XV + (w >> 1) * 1024 + lane * 16 + (w & 1) * 8) = pv; }
            SC_BAR();
            bf16x8 Vb[2];
#pragma unroll
            for (int k2 = 0; k2 < 2; ++k2) Vb[k2] = *(const LAS bf16x8*)(XV + k2 * 1024 + lane * 16);
            S0 = S0 * gl; S1 = S1 * gl;
#pragma unroll
            for (int k2 = 0; k2 < 2; ++k2) { oa = MFMA16(QKf[k2], Vb[k2], oa); S0 = MFMA16(KDf[0][k2], Vb[k2], S0); S1 = MFMA16(KDf[1][k2], Vb[k2], S1); }
            *(LAS bf16x8*)(XS + w * 1024 + lane * 16) = pack8(S0, S1);
            { const size_t t0 = (size_t)b * SEQ + (size_t)(q * 64 + n) * 64; float* op = O + (t0 + 16 * w + 4 * fq) * DM + h * 128 + dv0 + fr;
#pragma unroll
              for (int e = 0; e < 4; ++e) op[e * DM] = oa[e]; }
            SC_BAR();
        }
        if (q < 3) { st[(2 * w) * 64] = S0; st[(2 * w + 1) * 64] = S1; }
    }
#undef SC_BAR
}

__device__ __forceinline__ void attn_phase(const Params& p, char* lds, int wg, int G) {
    using bf = att::bf16;
    const bf* Qb = (const bf*)(p.ws + WS_BIG); const bf* Kb = (const bf*)(p.ws + WS_BIG + 64 * MiB); const bf* Vb = (const bf*)(p.ws + WS_BIG + 128 * MiB);
    bf* Ob = (bf*)p.out;
    constexpr int TOTAL = 1024;
    auto mkref = [&](int L, int pass) {
        int hidx, x;
        if ((G & 7) == 0) { const int xcd = L & 7, k = L >> 3; hidx = (k >> 5) * 8 + xcd; x = k & 31; } else { hidx = L >> 5; x = L & 31; }
        const int qb = pass ? x : 63 - x,     bh = hidx >> 2, m = (hidx >> 1) & 1, vh = hidx & 1, b = bh >> 2, h = bh & 3;
        att::BlockRef<bf, bf> r;
        r.Q = Qb + ((size_t)(bh * 2 + m) * SEQ + (size_t)qb * 256) * 128; r.K = Kb + (size_t)(bh * 2 + m) * SEQ * 128; r.V = Vb + (size_t)(bh * 2 + vh) * SEQ * 128;
        r.O = Ob + ((size_t)m * TT + (size_t)b * SEQ + (size_t)qb * 256) * DM + h * 256 + vh * 128; r.P0 = qb * 256;
        return r; };
    int L = wg; if (L >= TOTAL) return;
    int pass = 0;
    att::BlockRef<bf, bf> cur = mkref(L, 0);
    att::Seam<bf> S;
    int Wv = 1 << 30, skv = SEQ; asm volatile("" : "+s"(Wv), "+s"(skv));
    att::causal_swa_prime<bf, bf>(cur, Wv, lds, S);
    for (;;) {
        const bool more_pass = pass == 0, more_item = L + G < TOTAL, last = !more_pass && !more_item;
        int passn = pass + 1, Ln = L;
        if (!more_pass) { passn = 0; Ln = more_item ? L + G : L; }
        const att::BlockRef<bf, bf> nxt = last ? cur : mkref(Ln, passn);
        att::causal_swa_block<bf, bf>(cur, nxt, skv, Wv, lds, S);
        if (last) break;
        cur = nxt; pass = passn; L = Ln;
    }
}

#define XB_TMO      128
#define XB_XCNT(j)  (256  + 64 * (j))
#define XB_XSUB(j)  (1280 + 64 * (j))
#define XB_XGEN(j)  (2304 + 64 * (j))
#define XB_TOP      3328
#define XB_TOPGEN   3392
#define XCD_BAR_WORDS 3456
#define XB_SPIN_CAP (1u << 18)

__device__ __forceinline__ unsigned xb_ld(unsigned* p)              { return __hip_atomic_load(p, __ATOMIC_RELAXED, __HIP_MEMORY_SCOPE_AGENT); }
__device__ __forceinline__ unsigned xb_add(unsigned* p, unsigned v) { return __hip_atomic_fetch_add(p, v, __ATOMIC_RELAXED, __HIP_MEMORY_SCOPE_AGENT); }
__device__ __forceinline__ unsigned xb_xcc_id() { return (unsigned)__builtin_amdgcn_s_getreg((3 << 11) | 20) & 0xFu; }
#define XB_SPIN(cond, bar) do { unsigned _sp = 0; while (cond) { __builtin_amdgcn_s_sleep(1); \
    if ((++_sp & 255u) == 0u) { if (xb_ld(&(bar)[XB_TMO])) break; if (_sp > XB_SPIN_CAP) { atomicAdd(&(bar)[XB_TMO], 1u); break; } } } } while (0)

struct XcdBarrier {
    unsigned* bar; unsigned x;
    volatile LAS unsigned* st;
};

__device__ __forceinline__ XcdBarrier xcd_barrier_post(unsigned* bar, volatile LAS unsigned* st) {
    XcdBarrier b; b.bar = bar; b.x = xb_xcc_id(); b.st = st;
    if (threadIdx.x == 0) (void)xb_add(&bar[XB_XCNT(b.x)], 1u);
    return b;
}
__device__ __forceinline__ void xcd_barrier_complete(unsigned* bar, unsigned x, unsigned& nloc, unsigned& nx) {
    const unsigned G = gridDim.x * gridDim.y * gridDim.z;
    unsigned sum, cnt, mine, sp = 0u;
    for (;;) {
        sum = 0u; cnt = 0u; mine = 0u;
#pragma unroll
        for (unsigned j = 0; j < 16; ++j) { const unsigned c = xb_ld(&bar[XB_XCNT(j)]); sum += c; cnt += (c > 0u) ? 1u : 0u; mine = (j == x) ? c : mine; }
        if (sum == G) break;
        __builtin_amdgcn_s_sleep(1);
        if ((++sp & 255u) == 0u) { if (xb_ld(&bar[XB_TMO])) break; if (sp > XB_SPIN_CAP) { atomicAdd(&bar[XB_TMO], 1u); break; } }
    }
    nloc = mine > 0u ? mine : 1u; nx = cnt > 0u ? cnt : 1u;
}

__device__ __forceinline__ void xcd_barrier(const XcdBarrier& b) {
    asm volatile("s_waitcnt vmcnt(0)" ::: "memory");
    __syncthreads();
    if (threadIdx.x == 0) {
        unsigned* bar = b.bar;
        __builtin_amdgcn_s_waitcnt(0);
        unsigned nloc = b.st[0], nx = b.st[1];
        if (nloc == 0u) { xcd_barrier_complete(bar, b.x, nloc, nx); b.st[0] = nloc; b.st[1] = nx; }
        const unsigned old = xb_add(&bar[XB_XSUB(b.x)], 1u);
        const unsigned gen = old / nloc;
        if (old + 1u == (gen + 1u) * nloc) {
            __builtin_amdgcn_fence(__ATOMIC_RELEASE, "agent");
            asm volatile("s_waitcnt vmcnt(0)" ::: "memory");
            const unsigned og = xb_add(&bar[XB_TOP], 1u);
            const unsigned tg = og / nx;
            if (og + 1u == (tg + 1u) * nx) xb_add(&bar[XB_TOPGEN], 1u);
            else XB_SPIN(xb_ld(&bar[XB_TOPGEN]) == tg, bar);
            __builtin_amdgcn_fence(__ATOMIC_ACQUIRE, "agent");
            xb_add(&bar[XB_XGEN(b.x)], 1u);
            asm volatile("s_waitcnt vmcnt(0)" ::: "memory");
        } else {
            XB_SPIN(xb_ld(&bar[XB_XGEN(b.x)]) == gen, bar);
            __builtin_amdgcn_fence(__ATOMIC_ACQUIRE, "agent");
            asm volatile("s_waitcnt vmcnt(0)" ::: "memory");
        }
    }
    __syncthreads();
}
constexpr size_t WS_BARW = 7 * MiB;
constexpr int LDS_BARST = 131072 + 64;
__device__ __forceinline__ Params load_params(const Params& p) {
#if defined(__HIP_DEVICE_COMPILE__)
    const __attribute__((address_space(4))) Params* pq = (const __attribute__((address_space(4))) Params*)__builtin_amdgcn_kernarg_segment_ptr();
    asm volatile("" : "+s"(pq)); Params q = *pq; return q;
#else
    return p;
#endif
}
__global__ void __launch_bounds__(512, 2) mega(Params p) {
    extern __shared__ __attribute__((aligned(16))) unsigned char lds_raw[];
    LAS unsigned char* lds = (LAS unsigned char*)lds_raw;
    const int tid0 = threadIdx.x, wg0 = blockIdx.x, G0 = gridDim.x, ph_lo = p.ph_lo, ph_hi = p.ph_hi;
    if (tid0 < 8) ((LAS unsigned*)(lds + LDS_BARST))[tid0] = 0u;
    __syncthreads();
    XcdBarrier bar; bar.bar = nullptr; bar.x = 0; bar.st = nullptr;
    if (ph_hi - ph_lo > 1) bar = xcd_barrier_post((unsigned*)(load_params(p).ws + WS_BARW), (volatile LAS unsigned*)(lds + LDS_BARST));
    if (ph_lo < -1000) cg::this_grid().sync();
#ifndef PHMASK
#define PHMASK 0xFFFFFFFFu
#endif
#define PHSEL(k) (1)
#ifndef REPMASK
#define REPMASK 0u
#endif
#define REPSEL(k) (0)
#define PH_BEGIN(k) if (PHSEL(k) && ph_lo <= (k) && (k) < ph_hi) for (int rep_ = 0; rep_ < 1 + REPSEL(k); ++rep_) { int tid = tid0, wg = wg0, G = G0; asm volatile("" : "+v"(tid), "+s"(wg), "+s"(G)); Params q = load_params(p); unsigned char* ws = q.ws; \
        float* modv = (float*)(ws + WS_MOD); float* kvmod = (float*)(ws + WS_KVMOD); bf16_t* HB = (bf16_t*)q.out; bf16_t* HB2 = (bf16_t*)((unsigned char*)q.out + 64 * MiB); bf16_t* HB3 = (bf16_t*)(ws + WS_HB3); bf16_t* STR = (bf16_t*)(ws + WS_HB); bf16_t* HBX = (bf16_t*)(ws + WS_HB2); (void)STR; (void)HBX; \
        bf16_t* BIG = (bf16_t*)(ws + WS_BIG); bf16_t* H0 = (bf16_t*)q.out; (void)modv; (void)kvmod; (void)HB; (void)HB2; (void)HB3; (void)BIG; (void)H0; (void)tid;
#define PH_END(k) } do { if (ph_lo <= (k) && (k) + 1 < ph_hi) { xcd_barrier(bar); } } while (0)
    PH_BEGIN(0) p0_prologue(q, lds, wg, G, tid); PH_END(0);
    PH_BEGIN(1) modulate_phase<true, false>(q, lds, q.in[0], q.in[4], modv + 0 * 1024, modv + 1 * 1024, 6144, H0, wg, G, tid); PH_END(1);
    PH_BEGIN(2) pg8::Gemm g{H0, (const bf16_t*)(ws + WS_WIN), TT, 4096, 1024}; pg8::StaticOrder S; S.init(TT, 4096, G, wg); pg8::EpiStoreBf16 E{BIG, 4096, 0, 1};
            pg8::gemm_phase<pg8::EpiStoreBf16, pg8::StaticOrder, true, true>(lds, g, S, E); PH_END(2);
    PH_BEGIN(3) prep_phase(q, lds, 0, wg, G, (1024 - wg + G - 1) / G, tid); PH_END(3);
#define GDN_STAGE(ph, k) PH_BEGIN(ph) if (wg < 128) { scan_phase(q, lds, (k) - 1, wg, tid); __syncthreads(); } \
        if (G == 256) { if (wg < 128) prep_phase(q, lds, (k), 896 + wg, 1, 1, tid); else prep_phase(q, lds, (k), (wg - 128) * 7, 1, 7, tid); } \
        else prep_phase(q, lds, (k), wg, G, (1024 - wg + G - 1) / G, tid); PH_END(ph);
    GDN_STAGE(4, 1)
    GDN_STAGE(5, 2)
    GDN_STAGE(6, 3)
    PH_BEGIN(7) if (wg < 128) scan_phase(q, lds, 3, wg, tid); if (G <= 128) __syncthreads(); if (wg >= 128 || G <= 128) p0_weights(q, lds, 1, G <= 128 ? wg : wg - 128, G <= 128 ? G : G - 128, tid); PH_END(7);
    PH_BEGIN(8) gate_phase(q.out, BIG, q.in[10], HBX, wg, G, tid); PH_END(8);
    PH_BEGIN(9) pg8::Gemm g{HBX, (const bf16_t*)(ws + WS_WAO), TT, 1024, 1024}; pg8::StaticOrder S; S.init(TT, 1024, G, wg); pg8::EpiResidS<true> E{q.in[0], STR, modv + 2 * 1024, 6144};
            pg8::gemm_phase<pg8::EpiResidS<true>, pg8::StaticOrder, true, true>(lds, g, S, E); PH_END(9);
#define MLP_PHASES(l, pb) \
    PH_BEGIN(pb) float* mv = modv + (l) * 2 * 6144; modulate_phase<false, true>(q, lds, STR, q.in[5] + (l) * 1024, mv + 3 * 1024, mv + 4 * 1024, 6144, HB, wg, G, tid); PH_END(pb); \
    PH_BEGIN(pb + 1) pg8::Gemm g{HB, (const bf16_t*)(ws + WS_W1 + (size_t)(l) * 16 * MiB), TT, 4096, 1024}; pg8::StaticOrder S; S.init(TT, 4096, G, wg); pg8::EpiStoreBf16 E{BIG, 4096, 1, 0}; \
            pg8::gemm_phase<pg8::EpiStoreBf16, pg8::StaticOrder, true, true>(lds, g, S, E); PH_END(pb + 1); \
    PH_BEGIN(pb + 2) float* mv = modv + (l) * 2 * 6144; pg8::Gemm g{BIG, (const bf16_t*)(ws + WS_W2 + (size_t)(l) * 16 * MiB), TT, 1024, 4096}; pg8::StaticOrder S; S.init(TT, 1024, G, wg); pg8::EpiResidS<false> E{STR, STR, mv + 5 * 1024, 6144}; \
            pg8::gemm_phase<pg8::EpiResidS<false>, pg8::StaticOrder, true, true>(lds, g, S, E); PH_END(pb + 2);
    MLP_PHASES(0, 10)
    PH_BEGIN(13) modulate2_phase(STR, q.in[14], kvmod, kvmod + 1024, 2048, HB2, q.in[4] + 1024, modv + 2 * 6144, modv + 2 * 6144 + 1024, 6144, HB, wg, G, tid); PH_END(13);
    PH_BEGIN(14) const float* rc = (const float*)(ws + WS_ROPEC); const float* rs = (const float*)(ws + WS_ROPES);
        { pg8::Gemm g{HB2, (const bf16_t*)(ws + WS_WKV), TT, 2048, 1024}; pg8::StaticOrder S; S.init(TT, 2048, G, wg); pg8::EpiRope E{BIG + 32 * MiB, BIG + 64 * MiB, rc, rs, 4};
          pg8::gemm_phase<pg8::EpiRope, pg8::StaticOrder, true, true>(lds, g, S, E); }
        __syncthreads();
        { unsigned char* ws2 = ws; int wg2 = wg, G2 = G; asm volatile("" : "+s"(ws2), "+s"(wg2), "+s"(G2)); const float* rc2 = (const float*)(ws2 + WS_ROPEC); const float* rs2 = (const float*)(ws2 + WS_ROPES); bf16_t* Q2 = (bf16_t*)(ws2 + WS_BIG);
          const bf16_t* HBq = HB; asm volatile("" : "+s"(HBq)); pg8::Gemm g{HBq, (const bf16_t*)(ws2 + WS_WQ), TT, 1024, 1024}; pg8::StaticOrder S; S.init(TT, 1024, G2, wg2); pg8::EpiRope E{Q2, Q2, rc2, rs2, 4};
          pg8::gemm_phase<pg8::EpiRope, pg8::StaticOrder, true, true>(lds, g, S, E); } PH_END(14);
    PH_BEGIN(15) attn_phase(q, (char*)lds_raw, wg, G); PH_END(15);
    PH_BEGIN(16) combine_phase(q, (const bf16_t*)q.out, HB3, wg, G, tid); PH_END(16);
    PH_BEGIN(17) pg8::Gemm g{HB3, (const bf16_t*)(ws + WS_WBO), TT, 1024, 1024}; pg8::StaticOrder S; S.init(TT, 1024, G, wg); pg8::EpiResidS<false> E{STR, STR, modv + 2 * 6144 + 2 * 1024, 6144};
        pg8::gemm_phase<pg8::EpiResidS<false>, pg8::StaticOrder, true, true>(lds, g, S, E); PH_END(17);
    MLP_PHASES(1, 18)
    PH_BEGIN(21) final_phase(STR, q.out, q.in[22], wg, G, tid); }
#undef PH_BEGIN
#undef PH_END
}

extern "C" void kernel_launch(void* const* d_in, const int* in_sizes, int n_in, void* d_out, int out_size, void* d_ws, size_t ws_size, hipStream_t stream) {
    static int grid = 0;
    if (grid == 0) {
        if (n_in != 23 || out_size != TT * DM || ws_size < WS_END) { fprintf(stderr, "kernel_launch: unexpected shapes n_in %d out %d ws %zu\n", n_in, out_size, ws_size); grid = -1; return; }
        int dev = 0, cus = 0, per_cu = 0;
        (void)hipGetDevice(&dev); (void)hipDeviceGetAttribute(&cus, hipDeviceAttributeMultiprocessorCount, dev);
        if (hipFuncSetAttribute((const void*)mega, hipFuncAttributeMaxDynamicSharedMemorySize, LDS_BYTES) != hipSuccess) { fprintf(stderr, "kernel_launch: hipFuncSetAttribute failed\n"); grid = -1; return; }
        if (hipOccupancyMaxActiveBlocksPerMultiprocessor(&per_cu, (const void*)mega, 512, LDS_BYTES) != hipSuccess || per_cu < 1) { fprintf(stderr, "kernel_launch: occupancy query says %d\n", per_cu); per_cu = 1; }
        (void)hipGetLastError();
        grid = cus * 1;
        if (grid <= 0) grid = 256;
    }
    if (grid < 0) return;
    Params p{};
    for (int i = 0; i < 23; ++i) p.in[i] = (const float*)d_in[i];
    p.out = (float*)d_out; p.ws = (unsigned char*)d_ws;
#if MK_SINGLE
    if (hipMemsetAsync((unsigned char*)d_ws + WS_BARW, 0, XCD_BAR_WORDS * 4, stream) != hipSuccess) { fprintf(stderr, "kernel_launch: memset of the barrier words failed\n"); return; }
    p.ph_lo = 0; p.ph_hi = NPH;
    void* args[] = {&p};
    hipError_t e = hipLaunchCooperativeKernel((const void*)mega, dim3(grid), dim3(512), args, LDS_BYTES, stream);
    if (e != hipSuccess) fprintf(stderr, "cooperative launch failed: %s (grid %d)\n", hipGetErrorString(e), grid);
#else
    for (int ph = 0; ph < NPH; ++ph) { p.ph_lo = ph; p.ph_hi = ph + 1; hipLaunchKernelGGL(mega, dim3(grid), dim3(512), LDS_BYTES, stream, p); }
#endif
}
```
